# Optimizing an MI355X kernel written in HIP

```python
import jax
import jax.numpy as jnp
from jax import lax
import numpy as np


D_MODEL = 1024
BATCH = 8
SEQ = 2048
DEPTH = 1

M_WIDTH = D_MODEL
M_HEADS = 4
M_HEAD_DIM = M_WIDTH // M_HEADS
M_CHUNK = 128
CONV_WIDTH = 4
A_GROUPS = ((128, 1), (512, 4), (2048, 16))
N_GROUPS = 3
A_HEADS_PER_GROUP = 4
A_HEAD_DIM = 128
A_OUT_WIDTH = A_HEADS_PER_GROUP * A_HEAD_DIM
A_QKV_WIDTH = N_GROUPS * A_OUT_WIDTH
A_BLOCK = 128
ROPE_DIM = A_HEAD_DIM // 4
ROPE_THETA = 500000.0
NORM_EPS = 1e-6
NEG_INF = -1e30
IN_SPLITS = (M_WIDTH, M_WIDTH, M_WIDTH, M_WIDTH, M_WIDTH, 2 * M_HEADS, A_QKV_WIDTH, A_QKV_WIDTH, A_QKV_WIDTH, A_OUT_WIDTH, D_MODEL, D_MODEL)
IN_WIDTH = 5 * M_WIDTH + 2 * M_HEADS + 3 * A_QKV_WIDTH + A_OUT_WIDTH + 2 * D_MODEL

kernel_name = 'hybrid_mlstm_dilated_attn_block'


def rmsnorm(x, w):
    xf = x.astype(jnp.float32)
    y = xf * lax.rsqrt(jnp.mean(xf * xf, axis=-1, keepdims=True) + NORM_EPS) * w.astype(jnp.float32)
    return y.astype(x.dtype)


def causal_depthwise_conv(x, w, b):
    C = x.shape[-1]
    y = lax.conv_general_dilated(x, w.astype(x.dtype)[:, None, :], window_strides=(1,), padding=[(CONV_WIDTH - 1, 0)], dimension_numbers=('NWC', 'WIO', 'NWC'), feature_group_count=C)
    return y + b.astype(x.dtype)


def apply_partial_rope(x, cos, sin):
    half = ROPE_DIM // 2
    c = cos[None, :, None, :]
    s = sin[None, :, None, :]
    x1 = x[..., :half]
    x2 = x[..., half:ROPE_DIM]
    return jnp.concatenate([x1 * c - x2 * s, x2 * c + x1 * s, x[..., ROPE_DIM:]], axis=-1)


def mlstm_chunkwise(q, k, v, i_pre, log_f):
    B, H, S, Dk = q.shape
    Dv = v.shape[-1]
    L = M_CHUNK
    nc = S // L
    qc = q.reshape(B, H, nc, L, Dk)
    kc = k.reshape(B, H, nc, L, Dk)
    vc = v.reshape(B, H, nc, L, Dv)
    ic = i_pre.reshape(B, H, nc, L)
    b = jnp.cumsum(log_f.reshape(B, H, nc, L), axis=-1)
    b_tot = b[..., -1]
    a = b_tot[..., None] - b + ic

    def step(carry, inp):
        C, n, m = carry
        k_j, v_j, a_j, bt_j = inp
        m_new = jnp.maximum(bt_j + m, a_j.max(-1))
        decay = jnp.exp(bt_j + m - m_new)
        w = jnp.exp(a_j - m_new[..., None])
        C_new = decay[..., None, None] * C + jnp.einsum('bhl,bhlk,bhlv->bhkv', w, k_j, v_j)
        n_new = decay[..., None] * n + jnp.einsum('bhl,bhlk->bhk', w, k_j)
        return (C_new, n_new, m_new), (C, n, m)

    init = (jnp.zeros((B, H, Dk, Dv), jnp.float32), jnp.zeros((B, H, Dk), jnp.float32), jnp.zeros((B, H), jnp.float32))
    xs = (jnp.moveaxis(kc, 2, 0), jnp.moveaxis(vc, 2, 0), jnp.moveaxis(a, 2, 0), jnp.moveaxis(b_tot, 2, 0))
    _, (C_prev, n_prev, m_prev) = lax.scan(step, init, xs)
    C_prev = jnp.moveaxis(C_prev, 0, 2)
    n_prev = jnp.moveaxis(n_prev, 0, 2)
    m_prev = jnp.moveaxis(m_prev, 0, 2)

    causal = jnp.tril(jnp.ones((L, L), dtype=bool))
    log_d = jnp.where(causal, b[..., :, None] - b[..., None, :] + ic[..., None, :], NEG_INF)
    inter_log = b + m_prev[..., None]
    m_t = jnp.maximum(inter_log, log_d.max(-1))
    s = jnp.einsum('bhnld,bhnsd->bhnls', qc, kc) * jnp.exp(log_d - m_t[..., None])
    inter = jnp.exp(inter_log - m_t)
    num = inter[..., None] * jnp.einsum('bhnld,bhndv->bhnlv', qc, C_prev) + jnp.einsum('bhnls,bhnsv->bhnlv', s, vc)
    den = inter * jnp.einsum('bhnld,bhnd->bhnl', qc, n_prev) + s.sum(-1)
    h = num / jnp.maximum(jnp.abs(den), jnp.exp(-m_t))[..., None]
    return h.reshape(B, H, S, Dv)


def dilated_window_attention(q, k, v, window, dilation):
    B, S, H, Dh = q.shape
    band = window // dilation
    Ls = S // dilation
    nblk = -(-Ls // A_BLOCK)
    Lp = nblk * A_BLOCK

    def by_residue(t):
        return t.reshape(B, Ls, dilation, H, Dh).transpose(0, 2, 3, 1, 4)

    qs, ks, vs = by_residue(q), by_residue(k), by_residue(v)
    qb = jnp.pad(qs, ((0, 0), (0, 0), (0, 0), (0, Lp - Ls), (0, 0))).reshape(B, dilation, H, nblk, A_BLOCK, Dh)

    def key_blocks(t):
        tp = jnp.pad(t, ((0, 0), (0, 0), (0, 0), (A_BLOCK, Lp - Ls), (0, 0)))
        prev = tp[..., :Lp, :].reshape(B, dilation, H, nblk, A_BLOCK, Dh)
        cur = tp[..., A_BLOCK:, :].reshape(B, dilation, H, nblk, A_BLOCK, Dh)
        return jnp.concatenate([prev, cur], axis=-2)

    kb, vb = key_blocks(ks), key_blocks(vs)
    t_idx = jnp.arange(A_BLOCK)[:, None]
    j_idx = jnp.arange(2 * A_BLOCK)[None, :]
    dist = t_idx - j_idx + A_BLOCK
    kpos = jnp.arange(nblk)[:, None, None] * A_BLOCK - A_BLOCK + j_idx[None]
    valid = (dist >= 0) & (dist <= band) & (kpos >= 0)
    s = jnp.einsum('bdhnqe,bdhnke->bdhnqk', qb, kb) * (A_HEAD_DIM ** -0.5)
    s = jnp.where(valid, s, NEG_INF)
    m = s.max(-1)
    p = jnp.where(valid, jnp.exp(s - m[..., None]), 0.0)
    l = p.sum(-1)
    o = jnp.einsum('bdhnqk,bdhnke->bdhnqe', p, vb) / jnp.where(l > 0, l, 1.0)[..., None]
    o = o.reshape(B, dilation, H, Lp, Dh)[..., :Ls, :].transpose(0, 3, 1, 2, 4).reshape(B, S, H, Dh)
    m = m.reshape(B, dilation, H, Lp)[..., :Ls].transpose(0, 3, 1, 2).reshape(B, S, H)
    l = l.reshape(B, dilation, H, Lp)[..., :Ls].transpose(0, 3, 1, 2).reshape(B, S, H)
    return o, m, l


def hybrid_layer(x, pre_w, w_in, b_if, conv_w, conv_b, m_norm_w, w_pm, w_pa, w_out, post_w):
    B, S, _ = x.shape
    f32 = jnp.float32
    h = rmsnorm(x, pre_w)
    proj = h @ w_in.astype(x.dtype)
    idx = np.cumsum(np.array(IN_SPLITS))[:-1].tolist()
    q_m, k_m, v_m, o_m, z_m, if_pre, q_a, k_a, v_a, z_a, g_m, g_a = jnp.split(proj, idx, axis=-1)

    qk = jax.nn.silu(causal_depthwise_conv(jnp.concatenate([q_m, k_m], axis=-1), conv_w, conv_b))
    q_m, k_m = qk[..., :M_WIDTH], qk[..., M_WIDTH:]

    def to_heads(t):
        return t.astype(f32).reshape(B, S, M_HEADS, M_HEAD_DIM).transpose(0, 2, 1, 3)

    gates = if_pre.astype(f32) + b_if.astype(f32)
    i_pre = gates[..., :M_HEADS].transpose(0, 2, 1)
    log_f = jax.nn.log_sigmoid(gates[..., M_HEADS:]).transpose(0, 2, 1)
    hm = mlstm_chunkwise(to_heads(q_m), to_heads(k_m) * (M_HEAD_DIM ** -0.5), to_heads(v_m), i_pre, log_f)
    hm = hm.transpose(0, 2, 1, 3) * jax.nn.sigmoid(o_m.astype(f32)).reshape(B, S, M_HEADS, M_HEAD_DIM)
    hm = hm * lax.rsqrt(jnp.mean(hm * hm, axis=-1, keepdims=True) + NORM_EPS) * m_norm_w.astype(f32).reshape(M_HEADS, M_HEAD_DIM)
    hm = hm.reshape(B, S, M_WIDTH).astype(x.dtype) * jax.nn.silu(z_m)
    branch_m = hm @ w_pm.astype(x.dtype)

    pos = jnp.arange(S, dtype=f32)
    inv_freq = ROPE_THETA ** (-jnp.arange(0, ROPE_DIM, 2, dtype=f32) / ROPE_DIM)
    ang = pos[:, None] * inv_freq[None, :]
    cos, sin = jnp.cos(ang), jnp.sin(ang)
    qa = q_a.astype(f32).reshape(B, S, N_GROUPS, A_HEADS_PER_GROUP, A_HEAD_DIM)
    ka = k_a.astype(f32).reshape(B, S, N_GROUPS, A_HEADS_PER_GROUP, A_HEAD_DIM)
    va = v_a.astype(f32).reshape(B, S, N_GROUPS, A_HEADS_PER_GROUP, A_HEAD_DIM)
    outs, maxes, dens = [], [], []
    for g, (window, dilation) in enumerate(A_GROUPS):
        o, m, l = dilated_window_attention(apply_partial_rope(qa[:, :, g], cos, sin), apply_partial_rope(ka[:, :, g], cos, sin), va[:, :, g], window, dilation)
        outs.append(o)
        maxes.append(m)
        dens.append(l)
    outs = jnp.stack(outs)
    maxes = jnp.stack(maxes)
    dens = jnp.stack(dens)
    wts = jnp.exp(maxes - maxes.max(0, keepdims=True)) * dens
    att = (wts[..., None] * outs).sum(0) / wts.sum(0)[..., None]
    att = att.reshape(B, S, A_OUT_WIDTH).astype(x.dtype) * jax.nn.silu(z_a)
    branch_a = att @ w_pa.astype(x.dtype)

    merged = jax.nn.sigmoid(g_m) * branch_m + jax.nn.sigmoid(g_a) * branch_a
    y = merged @ w_out.astype(x.dtype)
    return x + rmsnorm(y, post_w)


def setup_inputs(seed: int = 0) -> dict:
    key = jax.random.key(seed)
    ks = jax.random.split(key, 12)
    f32 = jnp.float32
    nrm = jax.random.normal
    x = nrm(ks[0], (BATCH, SEQ, D_MODEL), f32)
    pre_norm_w = 1.0 + 0.05 * nrm(ks[1], (DEPTH, D_MODEL), f32)
    w_in = nrm(ks[2], (DEPTH, D_MODEL, IN_WIDTH), f32) * D_MODEL ** -0.5
    b_if = jnp.concatenate([0.1 * nrm(ks[3], (DEPTH, M_HEADS), f32), jnp.linspace(3.0, 6.0, M_HEADS, dtype=f32)[None, :] + 0.1 * nrm(ks[4], (DEPTH, M_HEADS), f32)], axis=-1)
    conv_w = nrm(ks[5], (DEPTH, CONV_WIDTH, 2 * M_WIDTH), f32) * CONV_WIDTH ** -0.5
    conv_b = 0.01 * nrm(ks[6], (DEPTH, 2 * M_WIDTH), f32)
    m_norm_w = 1.0 + 0.05 * nrm(ks[7], (DEPTH, M_WIDTH), f32)
    w_proj_m = nrm(ks[8], (DEPTH, M_WIDTH, D_MODEL), f32) * M_WIDTH ** -0.5
    w_proj_a = nrm(ks[9], (DEPTH, A_OUT_WIDTH, D_MODEL), f32) * A_OUT_WIDTH ** -0.5
    w_out = nrm(ks[10], (DEPTH, D_MODEL, D_MODEL), f32) * D_MODEL ** -0.5
    post_norm_w = 1.0 + 0.05 * nrm(ks[11], (DEPTH, D_MODEL), f32)
    return {'x': x, 'pre_norm_w': pre_norm_w, 'w_in': w_in, 'b_if': b_if, 'conv_w': conv_w, 'conv_b': conv_b, 'm_norm_w': m_norm_w, 'w_proj_m': w_proj_m, 'w_proj_a': w_proj_a, 'w_out': w_out, 'post_norm_w': post_norm_w}


def reference(x, pre_norm_w, w_in, b_if, conv_w, conv_b, m_norm_w, w_proj_m, w_proj_a, w_out, post_norm_w):
    for layer in range(DEPTH):
        x = hybrid_layer(x, pre_norm_w[layer], w_in[layer], b_if[layer], conv_w[layer], conv_b[layer], m_norm_w[layer], w_proj_m[layer], w_proj_a[layer], w_out[layer], post_norm_w[layer])
    return x
```

```cpp
#include <hip/hip_runtime.h>
#include <hip/hip_cooperative_groups.h>
#include <cstdio>
namespace cg = cooperative_groups;

#define LAS __attribute__((address_space(3)))
typedef unsigned short bf16_t;
typedef short bf16x8 __attribute__((ext_vector_type(8)));
typedef float f32x4 __attribute__((ext_vector_type(4)));
typedef unsigned u32x4 __attribute__((ext_vector_type(4)));
typedef unsigned u32x2 __attribute__((ext_vector_type(2)));

constexpr int T_TOK = 16384, DM = 1024, SEQ = 2048, INW = 12296;
constexpr int LDS_BAR_OFF = 150784;
constexpr int LDS_BYTES = 150800;
#ifndef REP0
#define REP0 1
#endif
#ifndef REP1
#define REP1 1
#endif
#ifndef REP2
#define REP2 1
#endif
#ifndef REP8
#define REP8 1
#endif
#ifndef REPA
#define REPA 1
#endif
#ifndef REPB
#define REPB 1
#endif
#ifndef REP4
#define REP4 1
#endif
#ifndef MLX2
#define MLX2 1
#endif
#ifndef REPC
#define REPC 1
#endif
#ifndef REP7
#define REP7 1
#endif
constexpr float EPS = 1e-6f;
constexpr size_t WS_WIN = 0;
constexpr size_t WS_WPM = 25165824;
constexpr size_t WS_WPA = WS_WPM + 2097152;
constexpr size_t WS_WOUT = WS_WPA + 1048576;
constexpr size_t WS_GATES = WS_WOUT + 2097152;
constexpr size_t WS_R1 = WS_GATES + 524288;
constexpr size_t WS_R2 = WS_R1 + 167772160;
constexpr size_t WS_SSQ = WS_R2 + 67108864;
constexpr size_t WS_ROPE = WS_SSQ + 2097152;
constexpr size_t WS_BAR = WS_ROPE + 262144;
constexpr size_t WS_END = WS_BAR + 16384;
constexpr size_t OUT_H = 0, OUT_HM = 33554432, OUT_ML = 0, OUT_ATT = 4194304;
constexpr size_t R1_KA = 67108864, R1_VA = R1_KA + 50331648;
constexpr int QZ_LD = 2048;
constexpr size_t R1_TMP = 0, R1_MG = 67108864, R1_Y = 100663296;

struct Params {
    const float* x; const float* pre_w; const float* w_in; const float* b_if; const float* conv_w; const float* conv_b;
    const float* m_norm_w; const float* w_pm; const float* w_pa; const float* w_out; const float* post_w;
    float* out; unsigned char* ws; int ph_lo, ph_hi;
};

__device__ __forceinline__ float bf2f(unsigned b) { return __uint_as_float(b << 16); }
__device__ __forceinline__ float bflo(unsigned w) { return __uint_as_float(w << 16); }
__device__ __forceinline__ float bfhi(unsigned w) { return __uint_as_float(w & 0xffff0000u); }
typedef __bf16 bf16x2_t __attribute__((ext_vector_type(2)));
typedef float f32x2_t __attribute__((ext_vector_type(2)));
__device__ __forceinline__ unsigned cvt_pk_bf16(float lo, float hi) { const f32x2_t f = {lo, hi}; const bf16x2_t b = __builtin_convertvector(f, bf16x2_t); return __builtin_bit_cast(unsigned, b); }
__device__ __forceinline__ bf16_t f2bf(float f) { return (bf16_t)(cvt_pk_bf16(f, 0.f) & 0xffffu); }
__device__ __forceinline__ float sigmoidf_(float x) { return __builtin_amdgcn_rcpf(1.0f + __expf(-x)); }
__device__ __forceinline__ float siluf_(float x) { return x * sigmoidf_(x); }
__device__ __forceinline__ void unpack8(const u32x4 w, float (&f)[8]) {
    f[0] = bflo(w.x); f[1] = bfhi(w.x); f[2] = bflo(w.y); f[3] = bfhi(w.y); f[4] = bflo(w.z); f[5] = bfhi(w.z); f[6] = bflo(w.w); f[7] = bfhi(w.w);
}
__device__ __forceinline__ u32x4 pack8(const float (&f)[8]) {
    u32x4 w; w.x = cvt_pk_bf16(f[0], f[1]); w.y = cvt_pk_bf16(f[2], f[3]); w.z = cvt_pk_bf16(f[4], f[5]); w.w = cvt_pk_bf16(f[6], f[7]); return w;
}
__device__ __forceinline__ void st_wt16(void* p, u32x4 v) { asm volatile("global_store_dwordx4 %0, %1, off sc1\n\ts_nop 1" : : "v"(p), "v"(v) : "memory"); }
__device__ __forceinline__ void st_wt16_o256(void* p, u32x4 v) { asm volatile("global_store_dwordx4 %0, %1, off offset:256 sc1\n\ts_nop 1" : : "v"(p), "v"(v) : "memory"); }
typedef short s16x4 __attribute__((ext_vector_type(4)));
__device__ __forceinline__ u32x2 tr_read(LAS unsigned char* addr) { const s16x4 v = __builtin_amdgcn_ds_read_tr16_b64_v4i16((LAS s16x4*)addr); return __builtin_bit_cast(u32x2, v); }
__device__ __forceinline__ u32x4 ldg16(const void* base, unsigned off) { return *(const u32x4*)((const char*)base + off); }
__device__ __forceinline__ u32x2 ldg8(const void* base, unsigned off) { return *(const u32x2*)((const char*)base + off); }
__device__ __forceinline__ void stg8(void* base, unsigned off, u32x2 v) { *(u32x2*)((char*)base + off) = v; }
__device__ __forceinline__ float wave_sum(float v) {
    v += __shfl_xor(v, 32); v += __shfl_xor(v, 16); v += __shfl_xor(v, 8); v += __shfl_xor(v, 4); v += __shfl_xor(v, 2); v += __shfl_xor(v, 1); return v;
}

#define XB_TMO      128
#define XB_XCNT(j)  (256  + 64 * (j))
#define XB_XSUB(j)  (1280 + 64 * (j))
#define XB_XGEN(j)  (2304 + 64 * (j))
#define XB_TOP      3328
#define XB_TOPGEN   3392
#define XCD_BAR_WORDS 3456
#define XB_SPIN_CAP (1u << 18)
__device__ __forceinline__ unsigned xb_ld(unsigned* p)              { return __hip_atomic_load(p, __ATOMIC_RELAXED, __HIP_MEMORY_SCOPE_AGENT); }
__device__ __forceinline__ unsigned xb_add(unsigned* p, unsigned v) { return __hip_atomic_fetch_add(p, v, __ATOMIC_RELAXED, __HIP_MEMORY_SCOPE_AGENT); }
__device__ __forceinline__ unsigned xb_xcc_id() { return (unsigned)__builtin_amdgcn_s_getreg((3 << 11) | 20) & 0xFu; }
#define XB_SPIN(cond, bar) do { unsigned _sp = 0; while (cond) { __builtin_amdgcn_s_sleep(1); \
    if ((++_sp & 255u) == 0u) { if (xb_ld(&(bar)[XB_TMO])) break; if (_sp > XB_SPIN_CAP) { atomicAdd(&(bar)[XB_TMO], 1u); break; } } } } while (0)
struct XcdBarrier { unsigned* bar; unsigned x; volatile LAS unsigned* st; };
__device__ __forceinline__ XcdBarrier xcd_barrier_post(unsigned* bar, volatile LAS unsigned* st) {
    XcdBarrier b; b.bar = bar; b.x = xb_xcc_id(); b.st = st;
    if (threadIdx.x == 0) (void)xb_add(&bar[XB_XCNT(b.x)], 1u);
    return b;
}
__device__ __forceinline__ void xcd_barrier_complete(unsigned* bar, unsigned x, unsigned& nloc, unsigned& nx) {
    const unsigned G = gridDim.x * gridDim.y * gridDim.z;
    unsigned sum, cnt, mine, sp = 0u;
    for (;;) {
        sum = 0u; cnt = 0u; mine = 0u;
#pragma unroll
        for (unsigned j = 0; j < 16; ++j) { const unsigned c = xb_ld(&bar[XB_XCNT(j)]); sum += c; cnt += (c > 0u) ? 1u : 0u; mine = (j == x) ? c : mine; }
        if (sum == G) break;
        __builtin_amdgcn_s_sleep(1);
        if ((++sp & 255u) == 0u) { if (xb_ld(&bar[XB_TMO])) break; if (sp > XB_SPIN_CAP) { atomicAdd(&bar[XB_TMO], 1u); break; } }
    }
    nloc = mine > 0u ? mine : 1u; nx = cnt > 0u ? cnt : 1u;
}
__device__ __forceinline__ void xcd_barrier(const XcdBarrier& b) {
    asm volatile("s_waitcnt vmcnt(0)" ::: "memory");
    __syncthreads();
    if (threadIdx.x == 0) {
        unsigned* bar = b.bar;
        __builtin_amdgcn_s_waitcnt(0);
        unsigned nloc = b.st[0], nx = b.st[1];
        if (nloc == 0u) { xcd_barrier_complete(bar, b.x, nloc, nx); b.st[0] = nloc; b.st[1] = nx; }
        const unsigned old = xb_add(&bar[XB_XSUB(b.x)], 1u);
        const unsigned gen = old / nloc;
        if (old + 1u == (gen + 1u) * nloc) {
            __builtin_amdgcn_fence(__ATOMIC_RELEASE, "agent");
            asm volatile("s_waitcnt vmcnt(0)" ::: "memory");
            const unsigned og = xb_add(&bar[XB_TOP], 1u);
            const unsigned tg = og / nx;
            if (og + 1u == (tg + 1u) * nx) xb_add(&bar[XB_TOPGEN], 1u);
            else XB_SPIN(xb_ld(&bar[XB_TOPGEN]) == tg, bar);
            __builtin_amdgcn_fence(__ATOMIC_ACQUIRE, "agent");
            xb_add(&bar[XB_XGEN(b.x)], 1u);
            asm volatile("s_waitcnt vmcnt(0)" ::: "memory");
        } else {
            XB_SPIN(xb_ld(&bar[XB_XGEN(b.x)]) == gen, bar);
            __builtin_amdgcn_fence(__ATOMIC_ACQUIRE, "agent");
            asm volatile("s_waitcnt vmcnt(0)" ::: "memory");
        }
    }
    __syncthreads();
}

namespace pg8 {
constexpr int BM = 256, BK = 64, HALF = 128, HTB = HALF * BK * 2, STAGE_BYTES = 8 * HTB, NXCD = 8, WGM = 4;
__device__ __forceinline__ int lds_byte(int r, int c) { const int st = (r >> 4) * 2 + (c >> 5), rr = r & 15, cc = c & 31, ob = rr * 64 + cc * 2; return st * 1024 + (ob ^ (((ob >> 9) & 1) << 5)); }
__device__ __forceinline__ void stage_rc(int b, int& R, int& C) { const int st = b / 1024, sb = b % 1024, swz = sb ^ (((sb >> 9) & 1) << 5); R = (st >> 1) * 16 + swz / 64; C = (st & 1) * 32 + (swz % 64) / 2; }
__device__ __forceinline__ int perm32(int rho) { const int n = rho >> 4, i = rho & 15; return 8 * (i >> 2) + 4 * n + (i & 3); }
struct Unit { int pm, pn; };
struct Gemm { const bf16_t* A; const bf16_t* Bt; int M, N, K; };
struct StaticOrder {
    int nM, nN, nwg, G, c;
    __device__ void init(int M, int N, int G_, int c_) { nM = M / BM; nN = N / BM; nwg = nM * nN; G = G_; c = c_; }
    __device__ bool next(int i, Unit& u) const {
        const long L = (long)i * G + c; if (L >= nwg) return false;
        int wgid = (int)L; { const int q = nwg / NXCD, r = nwg % NXCD, xcd = wgid % NXCD, off = wgid / NXCD; wgid = (xcd < r ? xcd * (q + 1) : r * (q + 1) + (xcd - r) * q) + off; }
        const int nig = WGM * nN, gid = wgid / nig, fm = gid * WGM, gsz = (nM - fm) < WGM ? (nM - fm) : WGM;
        u.pm = fm + ((wgid % nig) % gsz); u.pn = (wgid % nig) / gsz; return true;
    }
};

template <class Epi, bool AFTER = false>
__device__ __forceinline__ void gemm_phase(LAS unsigned char* lds, const Gemm g, const StaticOrder& S, const Epi& E) {
    const int tid = threadIdx.x, wid = __builtin_amdgcn_readfirstlane(tid >> 6), lane = tid & 63, wr = wid >> 2, wc = wid & 3, fr = lane & 15, fq = lane >> 4;
    const int K = g.K, nt = K / BK;
    unsigned voffA[2], voffB[2];
#pragma unroll
    for (int i = 0; i < 2; ++i) { int R, C; stage_rc(tid * 16 + i * 8192, R, C); const int Rb = (R & ~31) + perm32(R & 31);
        voffA[i] = (unsigned)(R * K + C) * 2u; voffB[i] = (unsigned)(Rb * K + C) * 2u; }
    const size_t kstep = (size_t)(BK * 2);
    const size_t hstep = (size_t)HALF * K * 2;
    const size_t tstep = 2 * hstep;
    const unsigned ldsw = (unsigned)wid * 1024u;
    const int aoff = lds_byte(wr * 64 + fr, fq * 8), boff = lds_byte(wc * 32 + fr, fq * 8);
#define PG8_SA(b, h) (((b) * 2 + (h)) * HTB)
#define PG8_SB(b, h) ((4 + (b) * 2 + (h)) * HTB)
#define PG8_STAGE(bufoff, gbase, voff) do { _Pragma("unroll") for (int _i = 0; _i < 2; ++_i) \
        __builtin_amdgcn_global_load_lds((const unsigned*)((const char*)(gbase) + (voff)[_i]), (LAS unsigned*)(lds + (bufoff) + ldsw + _i * 8192), 16, 0, 0); } while (0)
#define PG8_LDA(dst, b, h) do { _Pragma("unroll") for (int m = 0; m < 4; ++m) _Pragma("unroll") for (int k = 0; k < 2; ++k) dst[m][k] = *(const LAS bf16x8*)(lds + PG8_SA(b, h) + aoff + m * 2048 + k * 1024); } while (0)
#define PG8_LDB(dst, b, h) do { _Pragma("unroll") for (int n = 0; n < 2; ++n) _Pragma("unroll") for (int k = 0; k < 2; ++k) dst[n][k] = *(const LAS bf16x8*)(lds + PG8_SB(b, h) + boff + n * 2048 + k * 1024); } while (0)
#define PG8_MMA(ai, bj, At, Bt) do { __builtin_amdgcn_s_setprio(1); _Pragma("unroll") for (int m = 0; m < 4; ++m) _Pragma("unroll") for (int n = 0; n < 2; ++n) _Pragma("unroll") for (int k = 0; k < 2; ++k) \
        acc[ai][bj][m][n] = __builtin_amdgcn_mfma_f32_16x16x32_bf16(Bt[n][k], At[m][k], acc[ai][bj][m][n], 0, 0, 0); __builtin_amdgcn_s_setprio(0); } while (0)
#define PG8_WAIT_V(n) asm volatile("s_waitcnt vmcnt(" #n ")" ::: "memory")
#define PG8_WAIT_L(n) asm volatile("s_waitcnt lgkmcnt(" #n ")" ::: "memory")
#define PG8_BAR __builtin_amdgcn_s_barrier()
#define PG8_SCHED __builtin_amdgcn_sched_barrier(0)
    Unit cur, nxt; int ui = 0;
    if (!S.next(0, cur)) return;
    f32x4 acc[2][2][4][2];
#pragma unroll
    for (int a = 0; a < 2; ++a)
#pragma unroll
        for (int b = 0; b < 2; ++b)
#pragma unroll
            for (int m = 0; m < 4; ++m)
#pragma unroll
                for (int n = 0; n < 2; ++n) acc[a][b][m][n] = (f32x4){0.f, 0.f, 0.f, 0.f};
    bf16x8 At[4][2], B0[2][2], B1[2][2];
    const char* cA = (const char*)g.A + (size_t)cur.pm * tstep; const char* cB = (const char*)g.Bt + (size_t)cur.pn * tstep;
    PG8_STAGE(PG8_SB(0, 0), cB, voffB); PG8_STAGE(PG8_SA(0, 0), cA, voffA); PG8_STAGE(PG8_SB(0, 1), cB + hstep, voffB); PG8_STAGE(PG8_SA(0, 1), cA + hstep, voffA);
    if (wr == 1) PG8_BAR;
    PG8_WAIT_V(4); PG8_BAR;
    PG8_STAGE(PG8_SB(1, 0), cB + kstep, voffB); PG8_STAGE(PG8_SA(1, 0), cA + kstep, voffA); PG8_STAGE(PG8_SB(1, 1), cB + hstep + kstep, voffB);
    PG8_WAIT_V(6); PG8_BAR;
    for (;;) {
        const bool has_next = S.next(ui + 1, nxt);
        const char* nA = has_next ? (const char*)g.A + (size_t)nxt.pm * tstep : cA; const char* nB = has_next ? (const char*)g.Bt + (size_t)nxt.pn * tstep : cB;
        for (int t = 0; t < nt; t += 2) {
            const bool last = (t == nt - 2);
            const char* a1 = cA + (size_t)(t + 1) * kstep;
            const char* a2 = last ? nA : cA + (size_t)(t + 2) * kstep; const char* b2 = last ? nB : cB + (size_t)(t + 2) * kstep;
            const char* a3 = a2 + kstep; const char* b3 = b2 + kstep;
            PG8_LDB(B0, 0, 0); PG8_SCHED; PG8_LDA(At, 0, 0); PG8_STAGE(PG8_SA(1, 1), a1 + hstep, voffA);
            PG8_WAIT_L(8); PG8_BAR; PG8_WAIT_L(0); PG8_MMA(0, 0, At, B0); PG8_BAR; PG8_SCHED;
            PG8_LDB(B1, 0, 1); PG8_STAGE(PG8_SB(0, 0), b2, voffB);
            PG8_BAR; PG8_WAIT_L(0); PG8_MMA(0, 1, At, B1); PG8_BAR;
            PG8_LDA(At, 0, 1); PG8_STAGE(PG8_SA(0, 0), a2, voffA);
            PG8_BAR; PG8_WAIT_L(0); PG8_MMA(1, 0, At, B0); PG8_BAR; PG8_SCHED;
            PG8_STAGE(PG8_SB(0, 1), b2 + hstep, voffB);
            PG8_WAIT_V(6); PG8_BAR; PG8_MMA(1, 1, At, B1); PG8_BAR;
            PG8_LDB(B0, 1, 0); PG8_SCHED; PG8_LDA(At, 1, 0); PG8_STAGE(PG8_SA(0, 1), a2 + hstep, voffA);
            PG8_WAIT_L(8); PG8_BAR; PG8_WAIT_L(0); PG8_MMA(0, 0, At, B0); PG8_BAR; PG8_SCHED;
            PG8_LDB(B1, 1, 1); PG8_STAGE(PG8_SB(1, 0), b3, voffB);
            PG8_BAR; PG8_WAIT_L(0); PG8_MMA(0, 1, At, B1); PG8_BAR;
            PG8_LDA(At, 1, 1); PG8_STAGE(PG8_SA(1, 0), a3, voffA);
            PG8_BAR; PG8_WAIT_L(0); PG8_MMA(1, 0, At, B0); PG8_BAR; PG8_SCHED;
            PG8_STAGE(PG8_SB(1, 1), b3 + hstep, voffB);
            PG8_WAIT_V(6); PG8_BAR; PG8_MMA(1, 1, At, B1); PG8_BAR;
        }
        if constexpr (!AFTER) E(acc, cur, wr, wc, fr, fq);
        if (!has_next) break;
#pragma unroll
        for (int a = 0; a < 2; ++a)
#pragma unroll
            for (int b = 0; b < 2; ++b)
#pragma unroll
                for (int m = 0; m < 4; ++m)
#pragma unroll
                    for (int n = 0; n < 2; ++n) acc[a][b][m][n] = (f32x4){0.f, 0.f, 0.f, 0.f};
        cur = nxt; cA = nA; cB = nB; ++ui;
    }
    PG8_WAIT_V(0);
    if (wr == 0) PG8_BAR;
    PG8_BAR;
    if constexpr (AFTER) E.fused(acc, cur, wr, wc, fr, fq, lds, wid, lane);
#undef PG8_SA
#undef PG8_SB
#undef PG8_STAGE
#undef PG8_LDA
#undef PG8_LDB
#undef PG8_MMA
#undef PG8_WAIT_V
#undef PG8_WAIT_L
#undef PG8_BAR
#undef PG8_SCHED
}
template <class EpiMid, class EpiEnd>
__device__ __forceinline__ void gemm_phase2(LAS unsigned char* lds, const Gemm g0, const Gemm g1, const StaticOrder& S, const EpiMid& Emid, const EpiEnd& Eend) {
    const int tid = threadIdx.x, wid = __builtin_amdgcn_readfirstlane(tid >> 6), lane = tid & 63, wr = wid >> 2, wc = wid & 3, fr = lane & 15, fq = lane >> 4;
    unsigned rA2[2], rB2[2], cb2[2];
#pragma unroll
    for (int i = 0; i < 2; ++i) { int R, C; stage_rc(tid * 16 + i * 8192, R, C); const int Rb = (R & ~31) + perm32(R & 31); rA2[i] = (unsigned)R * 2u; rB2[i] = (unsigned)Rb * 2u; cb2[i] = (unsigned)C * 2u; }
    const size_t kstep = (size_t)(BK * 2);
    const unsigned K0 = (unsigned)g0.K, K1 = (unsigned)g1.K;
    const size_t hstep0 = (size_t)HALF * g0.K * 2, hstep1 = (size_t)HALF * g1.K * 2;
    const unsigned ldsw = (unsigned)wid * 1024u;
    const int aoff = lds_byte(wr * 64 + fr, fq * 8), boff = lds_byte(wc * 32 + fr, fq * 8);
#define PG8_SA(b, h) (((b) * 2 + (h)) * HTB)
#define PG8_SB(b, h) ((4 + (b) * 2 + (h)) * HTB)
#define PG8_STAGE2(bufoff, gbase, r2, Ksel) do { \
        __builtin_amdgcn_global_load_lds((const unsigned*)((const char*)(gbase) + ((r2)[0] * (Ksel) + cb2[0])), (LAS unsigned*)(lds + (bufoff) + ldsw), 16, 0, 0); \
        __builtin_amdgcn_global_load_lds((const unsigned*)((const char*)(gbase) + ((r2)[1] * (Ksel) + cb2[1])), (LAS unsigned*)(lds + (bufoff) + ldsw + 8192), 16, 0, 0); } while (0)
#define PG8_LDA(dst, b, h) do { _Pragma("unroll") for (int m = 0; m < 4; ++m) _Pragma("unroll") for (int k = 0; k < 2; ++k) dst[m][k] = *(const LAS bf16x8*)(lds + PG8_SA(b, h) + aoff + m * 2048 + k * 1024); } while (0)
#define PG8_LDB(dst, b, h) do { _Pragma("unroll") for (int n = 0; n < 2; ++n) _Pragma("unroll") for (int k = 0; k < 2; ++k) dst[n][k] = *(const LAS bf16x8*)(lds + PG8_SB(b, h) + boff + n * 2048 + k * 1024); } while (0)
#define PG8_MMA(ai, bj, At, Bt) do { __builtin_amdgcn_s_setprio(1); _Pragma("unroll") for (int m = 0; m < 4; ++m) _Pragma("unroll") for (int n = 0; n < 2; ++n) _Pragma("unroll") for (int k = 0; k < 2; ++k) \
        acc[ai][bj][m][n] = __builtin_amdgcn_mfma_f32_16x16x32_bf16(Bt[n][k], At[m][k], acc[ai][bj][m][n], 0, 0, 0); __builtin_amdgcn_s_setprio(0); } while (0)
#define PG8_WAIT_V(n) asm volatile("s_waitcnt vmcnt(" #n ")" ::: "memory")
#define PG8_WAIT_L(n) asm volatile("s_waitcnt lgkmcnt(" #n ")" ::: "memory")
#define PG8_BAR __builtin_amdgcn_s_barrier()
#define PG8_SCHED __builtin_amdgcn_sched_barrier(0)
    Unit cur, nxt; int ui = 0;
    if (!S.next(0, cur)) return;
    f32x4 acc[2][2][4][2];
#pragma unroll
    for (int a = 0; a < 2; ++a)
#pragma unroll
        for (int b = 0; b < 2; ++b)
#pragma unroll
            for (int m = 0; m < 4; ++m)
#pragma unroll
                for (int n = 0; n < 2; ++n) acc[a][b][m][n] = (f32x4){0.f, 0.f, 0.f, 0.f};
    bf16x8 At[4][2], B0[2][2], B1[2][2];
    const char* cA = (const char*)g0.A + (size_t)cur.pm * 2 * hstep0; const char* cB = (const char*)g0.Bt + (size_t)cur.pn * 2 * hstep0;
    PG8_STAGE2(PG8_SB(0, 0), cB, rB2, K0); PG8_STAGE2(PG8_SA(0, 0), cA, rA2, K0);
    PG8_STAGE2(PG8_SB(0, 1), cB + hstep0, rB2, K0); PG8_STAGE2(PG8_SA(0, 1), cA + hstep0, rA2, K0);
    if (wr == 1) PG8_BAR;
    PG8_WAIT_V(4); PG8_BAR;
    PG8_STAGE2(PG8_SB(1, 0), cB + kstep, rB2, K0); PG8_STAGE2(PG8_SA(1, 0), cA + kstep, rA2, K0); PG8_STAGE2(PG8_SB(1, 1), cB + hstep0 + kstep, rB2, K0);
    PG8_WAIT_V(6); PG8_BAR;
    for (;;) {
        const bool has_next = S.next(ui + 1, nxt);
#pragma unroll 1
        for (int seg = 0; seg < 2; ++seg) {
            const int nt = (seg == 0 ? g0.K : g1.K) / BK;
            const size_t hs = seg == 0 ? hstep0 : hstep1, hsn = seg == 0 ? hstep1 : hstep0;
            const unsigned Kc = seg == 0 ? K0 : K1, Kn = seg == 0 ? K1 : K0;
            const Unit& nu = (seg == 0) ? cur : (has_next ? nxt : cur);
            const char* nA = (seg == 0) ? (const char*)g1.A + (size_t)nu.pm * 2 * hstep1 : (const char*)g0.A + (size_t)nu.pm * 2 * hstep0;
            const char* nB = (seg == 0) ? (const char*)g1.Bt + (size_t)nu.pn * 2 * hstep1 : (const char*)g0.Bt + (size_t)nu.pn * 2 * hstep0;
            for (int t = 0; t < nt; t += 2) {
                const bool last = (t == nt - 2);
                const char* a1 = cA + (size_t)(t + 1) * kstep;
                const char* a2 = last ? nA : cA + (size_t)(t + 2) * kstep; const char* b2 = last ? nB : cB + (size_t)(t + 2) * kstep;
                const char* a3 = a2 + kstep; const char* b3 = b2 + kstep;
                const size_t h2 = last ? hsn : hs;
                const unsigned K2 = last ? Kn : Kc;
                PG8_LDB(B0, 0, 0); PG8_SCHED; PG8_LDA(At, 0, 0); PG8_STAGE2(PG8_SA(1, 1), a1 + hs, rA2, Kc);
                PG8_WAIT_L(8); PG8_BAR; PG8_WAIT_L(0); PG8_MMA(0, 0, At, B0); PG8_BAR; PG8_SCHED;
                PG8_LDB(B1, 0, 1); PG8_STAGE2(PG8_SB(0, 0), b2, rB2, K2);
                PG8_BAR; PG8_WAIT_L(0); PG8_MMA(0, 1, At, B1); PG8_BAR;
                PG8_LDA(At, 0, 1); PG8_STAGE2(PG8_SA(0, 0), a2, rA2, K2);
                PG8_BAR; PG8_WAIT_L(0); PG8_MMA(1, 0, At, B0); PG8_BAR; PG8_SCHED;
                PG8_STAGE2(PG8_SB(0, 1), b2 + h2, rB2, K2);
                PG8_WAIT_V(6); PG8_BAR; PG8_MMA(1, 1, At, B1); PG8_BAR;
                PG8_LDB(B0, 1, 0); PG8_SCHED; PG8_LDA(At, 1, 0); PG8_STAGE2(PG8_SA(0, 1), a2 + h2, rA2, K2);
                PG8_WAIT_L(8); PG8_BAR; PG8_WAIT_L(0); PG8_MMA(0, 0, At, B0); PG8_BAR; PG8_SCHED;
                PG8_LDB(B1, 1, 1); PG8_STAGE2(PG8_SB(1, 0), b3, rB2, K2);
                PG8_BAR; PG8_WAIT_L(0); PG8_MMA(0, 1, At, B1); PG8_BAR;
                PG8_LDA(At, 1, 1); PG8_STAGE2(PG8_SA(1, 0), a3, rA2, K2);
                PG8_BAR; PG8_WAIT_L(0); PG8_MMA(1, 0, At, B0); PG8_BAR; PG8_SCHED;
                PG8_STAGE2(PG8_SB(1, 1), b3 + h2, rB2, K2);
                PG8_WAIT_V(6); PG8_BAR; PG8_MMA(1, 1, At, B1); PG8_BAR;
            }
            if (seg == 0) Emid(acc, cur, wr, wc, fr, fq); else Eend(acc, cur, wr, wc, fr, fq);
            cA = nA; cB = nB;
        }
        if (!has_next) break;
#pragma unroll
        for (int a = 0; a < 2; ++a)
#pragma unroll
            for (int b = 0; b < 2; ++b)
#pragma unroll
                for (int m = 0; m < 4; ++m)
#pragma unroll
                    for (int n = 0; n < 2; ++n) acc[a][b][m][n] = (f32x4){0.f, 0.f, 0.f, 0.f};
        cur = nxt; ++ui;
    }
    PG8_WAIT_V(0);
    if (wr == 0) PG8_BAR;
    PG8_BAR;
#undef PG8_SA
#undef PG8_SB
#undef PG8_STAGE2
#undef PG8_LDA
#undef PG8_LDB
#undef PG8_MMA
#undef PG8_WAIT_V
#undef PG8_WAIT_L
#undef PG8_BAR
#undef PG8_SCHED
}
}

#define EPI_LOOP_BEGIN \
    const int row0 = u.pm * 256 + wr * 64 + fr; \
    _Pragma("unroll") for (int ai = 0; ai < 2; ++ai) _Pragma("unroll") for (int m = 0; m < 4; ++m) { const int row = row0 + ai * 128 + m * 16; \
    _Pragma("unroll") for (int bj = 0; bj < 2; ++bj) { const f32x4 v0 = acc[ai][bj][m][0], v1 = acc[ai][bj][m][1];
#define EPI_LOOP_END } }

struct EpiStoreBf16 {
    bf16_t* O1; int ld1; int split_pn; bf16_t* O2; int ld2;
    __device__ __forceinline__ void operator()(const f32x4 (&acc)[2][2][4][2], const pg8::Unit& u, int wr, int wc, int fr, int fq) const {
        bf16_t* base; int ld, colt;
        if (u.pn < split_pn) { base = O1; ld = ld1; colt = u.pn * 256; } else { base = O2; ld = ld2; colt = (u.pn - split_pn) * 256; }
        const int col0 = colt + wc * 32 + 8 * fq; const int row0 = u.pm * 256 + wr * 64 + fr;
#pragma unroll
        for (int ai = 0; ai < 2; ++ai)
#pragma unroll
            for (int m = 0; m < 4; ++m) {
                bf16_t* rp = base + (size_t)(row0 + ai * 128 + m * 16) * ld + col0;
                u32x4 w0, w1;
                w0.x = cvt_pk_bf16(acc[ai][0][m][0][0], acc[ai][0][m][0][1]); w0.y = cvt_pk_bf16(acc[ai][0][m][0][2], acc[ai][0][m][0][3]);
                w0.z = cvt_pk_bf16(acc[ai][0][m][1][0], acc[ai][0][m][1][1]); w0.w = cvt_pk_bf16(acc[ai][0][m][1][2], acc[ai][0][m][1][3]);
                w1.x = cvt_pk_bf16(acc[ai][1][m][0][0], acc[ai][1][m][0][1]); w1.y = cvt_pk_bf16(acc[ai][1][m][0][2], acc[ai][1][m][0][3]);
                w1.z = cvt_pk_bf16(acc[ai][1][m][1][0], acc[ai][1][m][1][1]); w1.w = cvt_pk_bf16(acc[ai][1][m][1][2], acc[ai][1][m][1][3]);
                st_wt16(rp, w0); st_wt16_o256(rp, w1);
            }
    }
};
struct EpiProjB {
    bf16_t* QZ; bf16_t* KA; bf16_t* VA; bf16_t* Gm;
    __device__ __forceinline__ void operator()(const f32x4 (&acc)[2][2][4][2], const pg8::Unit& u, int wr, int wc, int fr, int fq) const {
        const int pn = u.pn; const int row0 = u.pm * 256 + wr * 64 + fr; const int cl = wc * 32 + 8 * fq;
#pragma unroll
        for (int ai = 0; ai < 2; ++ai)
#pragma unroll
            for (int m = 0; m < 4; ++m) {
                const int row = row0 + ai * 128 + m * 16;
                u32x4 w0, w1;
                w0.x = cvt_pk_bf16(acc[ai][0][m][0][0], acc[ai][0][m][0][1]); w0.y = cvt_pk_bf16(acc[ai][0][m][0][2], acc[ai][0][m][0][3]);
                w0.z = cvt_pk_bf16(acc[ai][0][m][1][0], acc[ai][0][m][1][1]); w0.w = cvt_pk_bf16(acc[ai][0][m][1][2], acc[ai][0][m][1][3]);
                w1.x = cvt_pk_bf16(acc[ai][1][m][0][0], acc[ai][1][m][0][1]); w1.y = cvt_pk_bf16(acc[ai][1][m][0][2], acc[ai][1][m][0][3]);
                w1.z = cvt_pk_bf16(acc[ai][1][m][1][0], acc[ai][1][m][1][1]); w1.w = cvt_pk_bf16(acc[ai][1][m][1][2], acc[ai][1][m][1][3]);
                if (pn < 6) { bf16_t* rp = QZ + (size_t)row * QZ_LD + pn * 256 + cl; st_wt16(rp, w0); st_wt16_o256(rp, w1); }
                else if (pn < 18) {
                    bf16_t* base = (pn < 12) ? KA : VA; const int c = (pn < 12 ? pn - 6 : pn - 12) * 256 + cl;
                    const int b = row >> 11, pos = row & 2047;
#pragma unroll
                    for (int bj = 0; bj < 2; ++bj) {
                        const int cc = c + bj * 128; const int g = cc >> 9, h = (cc >> 7) & 3, e = cc & 127; const int lg = 2 * g;
                        const int rr = pos & ((1 << lg) - 1), j = pos >> lg;
                        const size_t off = (size_t)g * ((size_t)T_TOK * 512) + ((size_t)((((b * 4 + h) << lg) + rr) * (2048 >> lg) + j)) * 128 + e;
                        st_wt16(base + off, bj == 0 ? w0 : w1);
                    }
                }
                else if (pn < 20) { bf16_t* rp = QZ + (size_t)row * QZ_LD + 1536 + (pn - 18) * 256 + cl; st_wt16(rp, w0); st_wt16_o256(rp, w1); }
                else { bf16_t* rp = Gm + (size_t)row * 2048 + (pn - 20) * 256 + cl; st_wt16(rp, w0); st_wt16_o256(rp, w1); }
            }
    }
};
struct EpiGateF32 {
    const bf16_t* Gt; float* TMP;
    __device__ __forceinline__ void operator()(const f32x4 (&acc)[2][2][4][2], const pg8::Unit& u, int wr, int wc, int fr, int fq) const {
        const int col0 = u.pn * 256 + wc * 32 + 8 * fq; const int row0 = u.pm * 256 + wr * 64 + fr;
#pragma unroll
        for (int ai = 0; ai < 2; ++ai) {
            u32x4 gw[4][2];
#pragma unroll
            for (int m = 0; m < 4; ++m)
#pragma unroll
                for (int bj = 0; bj < 2; ++bj) gw[m][bj] = *(const u32x4*)(Gt + (size_t)(row0 + ai * 128 + m * 16) * 2048 + col0 + bj * 128);
#pragma unroll
            for (int m = 0; m < 4; ++m)
#pragma unroll
                for (int bj = 0; bj < 2; ++bj) {
                    const f32x4 v0 = acc[ai][bj][m][0], v1 = acc[ai][bj][m][1]; float gf[8]; unpack8(gw[m][bj], gf);
                    f32x4 o0, o1;
                    o0[0] = sigmoidf_(gf[0]) * v0[0]; o0[1] = sigmoidf_(gf[1]) * v0[1]; o0[2] = sigmoidf_(gf[2]) * v0[2]; o0[3] = sigmoidf_(gf[3]) * v0[3];
                    o1[0] = sigmoidf_(gf[4]) * v1[0]; o1[1] = sigmoidf_(gf[5]) * v1[1]; o1[2] = sigmoidf_(gf[6]) * v1[2]; o1[3] = sigmoidf_(gf[7]) * v1[3];
                    float* tp = TMP + (size_t)(row0 + ai * 128 + m * 16) * 1024 + col0 + bj * 128; *(f32x4*)tp = o0; *(f32x4*)(tp + 4) = o1;
                }
        }
    }
};
struct EpiMerge {
    const bf16_t* Gt; const float* TMP; bf16_t* MG;
    __device__ __forceinline__ void operator()(const f32x4 (&acc)[2][2][4][2], const pg8::Unit& u, int wr, int wc, int fr, int fq) const {
        const int col0 = u.pn * 256 + wc * 32 + 8 * fq; const int row0 = u.pm * 256 + wr * 64 + fr;
#pragma unroll
        for (int ai = 0; ai < 2; ++ai)
#pragma unroll
            for (int mp = 0; mp < 2; ++mp) {
                u32x4 gw[2][2]; f32x4 t0[2][2], t1[2][2];
#pragma unroll
                for (int mm = 0; mm < 2; ++mm)
#pragma unroll
                    for (int bj = 0; bj < 2; ++bj) {
                        const size_t row = (size_t)(row0 + ai * 128 + (2 * mp + mm) * 16); const int col = col0 + bj * 128;
                        gw[mm][bj] = *(const u32x4*)(Gt + row * 2048 + 1024 + col);
                        const float* tp = TMP + row * 1024 + col; t0[mm][bj] = *(const f32x4*)tp; t1[mm][bj] = *(const f32x4*)(tp + 4);
                    }
#pragma unroll
                for (int mm = 0; mm < 2; ++mm)
#pragma unroll
                    for (int bj = 0; bj < 2; ++bj) {
                        const int m = 2 * mp + mm; const f32x4 v0 = acc[ai][bj][m][0], v1 = acc[ai][bj][m][1]; float gf[8]; unpack8(gw[mm][bj], gf);
                        float o[8];
                        o[0] = t0[mm][bj][0] + sigmoidf_(gf[0]) * v0[0]; o[1] = t0[mm][bj][1] + sigmoidf_(gf[1]) * v0[1]; o[2] = t0[mm][bj][2] + sigmoidf_(gf[2]) * v0[2]; o[3] = t0[mm][bj][3] + sigmoidf_(gf[3]) * v0[3];
                        o[4] = t1[mm][bj][0] + sigmoidf_(gf[4]) * v1[0]; o[5] = t1[mm][bj][1] + sigmoidf_(gf[5]) * v1[1]; o[6] = t1[mm][bj][2] + sigmoidf_(gf[6]) * v1[2]; o[7] = t1[mm][bj][3] + sigmoidf_(gf[7]) * v1[3];
                        *(u32x4*)(MG + (size_t)(row0 + ai * 128 + m * 16) * 1024 + col0 + bj * 128) = pack8(o);
                    }
            }
    }
};
struct EpiRatio {
    const bf16_t* Gt;
    __device__ __forceinline__ void operator()(f32x4 (&acc)[2][2][4][2], const pg8::Unit& u, int wr, int wc, int fr, int fq) const {
        unsigned goff = ((unsigned)(u.pm * 256 + wr * 64 + fr) * 2048u + (unsigned)(u.pn * 256 + wc * 32 + 8 * fq)) * 2u;
        asm volatile("" : "+v"(goff));
#pragma unroll
        for (int ai = 0; ai < 2; ++ai)
#pragma unroll
            for (int mp = 0; mp < 2; ++mp) {
                u32x4 gm[2][2], ga[2][2];
#pragma unroll
                for (int mm = 0; mm < 2; ++mm) {
                    const unsigned ro = goff + (unsigned)(ai * 128 + (2 * mp + mm) * 16) * 4096u;
#pragma unroll
                    for (int bj = 0; bj < 2; ++bj) { gm[mm][bj] = *(const u32x4*)((const char*)Gt + (ro + 256u * bj)); ga[mm][bj] = *(const u32x4*)((const char*)Gt + (ro + 2048u + 256u * bj)); }
                }
#pragma unroll
                for (int mm = 0; mm < 2; ++mm)
#pragma unroll
                    for (int bj = 0; bj < 2; ++bj) {
                        const int m = 2 * mp + mm; float fm[8], fa[8]; unpack8(gm[mm][bj], fm); unpack8(ga[mm][bj], fa);
#pragma unroll
                        for (int e = 0; e < 8; ++e) {
                            const float ratio = (1.0f + __expf(-fa[e])) * __builtin_amdgcn_rcpf(1.0f + __expf(-fm[e]));
                            acc[ai][bj][m][e >> 2][e & 3] *= ratio;
                        }
                    }
                asm volatile("" ::: "memory");
            }
    }
};
struct EpiMerge2 {
    const bf16_t* Gt; bf16_t* MG;
    __device__ __forceinline__ void operator()(f32x4 (&acc)[2][2][4][2], const pg8::Unit& u, int wr, int wc, int fr, int fq) const {
        const unsigned row0 = (unsigned)(u.pm * 256 + wr * 64 + fr), col0 = (unsigned)(u.pn * 256 + wc * 32 + 8 * fq);
        unsigned goff = (row0 * 2048u + 1024u + col0) * 2u, moff = (row0 * 1024u + col0) * 2u;
        asm volatile("" : "+v"(goff), "+v"(moff));
#pragma unroll
        for (int ai = 0; ai < 2; ++ai) {
            u32x4 ga[4][2];
#pragma unroll
            for (int m = 0; m < 4; ++m)
#pragma unroll
                for (int bj = 0; bj < 2; ++bj) ga[m][bj] = *(const u32x4*)((const char*)Gt + (goff + (unsigned)(ai * 128 + m * 16) * 4096u + 256u * bj));
#pragma unroll
            for (int m = 0; m < 4; ++m) {
                const unsigned rm = moff + (unsigned)(ai * 128 + m * 16) * 2048u;
#pragma unroll
                for (int bj = 0; bj < 2; ++bj) {
                    float fa[8], o[8]; unpack8(ga[m][bj], fa);
#pragma unroll
                    for (int e = 0; e < 8; ++e) o[e] = sigmoidf_(fa[e]) * acc[ai][bj][m][e >> 2][e & 3];
                    *(u32x4*)((char*)MG + (rm + 256u * bj)) = pack8(o);
                }
            }
            asm volatile("" ::: "memory");
        }
    }
};
struct EpiF32 {
    float* Y;
    __device__ __forceinline__ void operator()(const f32x4 (&acc)[2][2][4][2], const pg8::Unit& u, int wr, int wc, int fr, int fq) const {
        const int col0 = u.pn * 256 + wc * 32 + 8 * fq;
        EPI_LOOP_BEGIN
            float* yp = Y + (size_t)row * 1024 + col0 + bj * 128; *(f32x4*)yp = v0; *(f32x4*)(yp + 4) = v1;
        EPI_LOOP_END
    }
};

struct EpiRmsRes {
    const float* x; const float* post_w; float* out; float* X; unsigned* cnt;
    __device__ __forceinline__ void fused(f32x4 (&acc)[2][2][4][2], const pg8::Unit& u, int wr, int wc, int fr, int fq, LAS unsigned char* lds, int wid, int lane) const {
        LAS float* P = (LAS float*)lds;
        LAS float* S = (LAS float*)(lds + 4096);
        const int tid = threadIdx.x;
        const int col0 = u.pn * 256 + wc * 32 + 8 * fq;
        const size_t off0 = (size_t)(u.pm * 256 + wr * 64 + fr) * 1024 + col0;
        f32x4 xv[4][2][2];
#pragma unroll
        for (int m = 0; m < 4; ++m)
#pragma unroll
            for (int bj = 0; bj < 2; ++bj) { xv[m][bj][0] = *(const f32x4*)(x + off0 + (size_t)(m * 16) * 1024 + bj * 128); xv[m][bj][1] = *(const f32x4*)(x + off0 + (size_t)(m * 16) * 1024 + bj * 128 + 4); }
#pragma unroll
        for (int ai = 0; ai < 2; ++ai)
#pragma unroll
            for (int m = 0; m < 4; ++m) {
                float sq = 0.f;
#pragma unroll
                for (int bj = 0; bj < 2; ++bj)
#pragma unroll
                    for (int n = 0; n < 2; ++n) { const f32x4 v = acc[ai][bj][m][n]; sq += (v[0] * v[0] + v[1] * v[1]) + (v[2] * v[2] + v[3] * v[3]); }
                sq += __shfl_xor(sq, 16); sq += __shfl_xor(sq, 32);
                if (fq == 0) P[(ai * 128 + wr * 64 + m * 16 + fr) * 4 + wc] = sq;
            }
        __syncthreads();
        if (tid < 256) {
            const f32x4 pv = *(const LAS f32x4*)(P + tid * 4);
            __hip_atomic_store(X + ((size_t)u.pm * 256 + tid) * 4 + u.pn, (pv[0] + pv[1]) + (pv[2] + pv[3]), __ATOMIC_RELAXED, __HIP_MEMORY_SCOPE_AGENT);
        }
        asm volatile("s_waitcnt vmcnt(0)" ::: "memory");
        __syncthreads();
        if (tid == 0) {
            __hip_atomic_fetch_add(cnt + u.pm, 1u, __ATOMIC_RELAXED, __HIP_MEMORY_SCOPE_AGENT);
            for (unsigned sp = 0; sp < (1u << 22); ++sp) { if (__hip_atomic_load(cnt + u.pm, __ATOMIC_RELAXED, __HIP_MEMORY_SCOPE_AGENT) >= 4u) break; __builtin_amdgcn_s_sleep(1); }
            __builtin_amdgcn_fence(__ATOMIC_ACQUIRE, "agent");
            asm volatile("s_waitcnt vmcnt(0)" ::: "memory");
        }
        __syncthreads();
        if (tid < 256) {
            const float* xp = X + ((size_t)u.pm * 256 + tid) * 4;
            const float t = (__hip_atomic_load(xp, __ATOMIC_RELAXED, __HIP_MEMORY_SCOPE_AGENT) + __hip_atomic_load(xp + 1, __ATOMIC_RELAXED, __HIP_MEMORY_SCOPE_AGENT))
                          + (__hip_atomic_load(xp + 2, __ATOMIC_RELAXED, __HIP_MEMORY_SCOPE_AGENT) + __hip_atomic_load(xp + 3, __ATOMIC_RELAXED, __HIP_MEMORY_SCOPE_AGENT));
            S[tid] = rsqrtf(t * (1.0f / 1024.0f) + EPS);
        }
        __syncthreads();
        f32x4 pw[2][2];
#pragma unroll
        for (int bj = 0; bj < 2; ++bj) { pw[bj][0] = *(const f32x4*)(post_w + col0 + bj * 128); pw[bj][1] = *(const f32x4*)(post_w + col0 + bj * 128 + 4); }
#pragma unroll
        for (int ai = 0; ai < 2; ++ai) {
            if (ai == 1) {
#pragma unroll
                for (int m = 0; m < 4; ++m)
#pragma unroll
                    for (int bj = 0; bj < 2; ++bj) { xv[m][bj][0] = *(const f32x4*)(x + off0 + (size_t)(128 + m * 16) * 1024 + bj * 128); xv[m][bj][1] = *(const f32x4*)(x + off0 + (size_t)(128 + m * 16) * 1024 + bj * 128 + 4); }
            }
#pragma unroll
            for (int m = 0; m < 4; ++m) {
                const int lr = ai * 128 + wr * 64 + m * 16 + fr; const float rs = S[lr];
                const size_t off = off0 + (size_t)(ai * 128 + m * 16) * 1024;
#pragma unroll
                for (int bj = 0; bj < 2; ++bj) {
                    *(f32x4*)(out + off + bj * 128) = xv[m][bj][0] + acc[ai][bj][m][0] * rs * pw[bj][0];
                    *(f32x4*)(out + off + bj * 128 + 4) = xv[m][bj][1] + acc[ai][bj][m][1] * rs * pw[bj][1];
                }
            }
            asm volatile("" ::: "memory");
        }
    }
};

__device__ __forceinline__ void p0_prep(const Params& p, LAS unsigned char* lds) {
    const int tid = threadIdx.x, G = gridDim.x, bid = blockIdx.x, lane = tid & 63, wid = tid >> 6;
    unsigned char* ws = p.ws;
    LAS float* tile = (LAS float*)lds;
    LAS float* WG = (LAS float*)(lds + 32768);
    for (int i = tid; i < 2048; i += 512) { const int k = i >> 1, hf = i & 1; *(LAS f32x4*)(WG + k * 8 + hf * 4) = *(const f32x4*)(p.w_in + (size_t)k * INW + 5120 + hf * 4); }
    LAS float* strip = (LAS float*)(lds + 65536);
    for (int tI = bid; tI < 928; tI += G) {
        const float* src; bf16_t* dst; int ldn, Kdim, ns, kt, srccol;
        int u = tI;
        if (u < 768) { ns = u >> 4; kt = u & 15; src = p.w_in; ldn = INW; Kdim = 1024; dst = (bf16_t*)(ws + WS_WIN); srccol = ns * 256 + (ns >= 20 ? 8 : 0); }
        else if (u < 832) { u -= 768; ns = u >> 4; kt = u & 15; src = p.w_pm; ldn = 1024; Kdim = 1024; dst = (bf16_t*)(ws + WS_WPM); srccol = ns * 256; }
        else if (u < 864) { u -= 832; ns = u >> 3; kt = u & 7; src = p.w_pa; ldn = 1024; Kdim = 512; dst = (bf16_t*)(ws + WS_WPA); srccol = ns * 256; }
        else { u -= 864; ns = u >> 4; kt = u & 15; src = p.w_out; ldn = 1024; Kdim = 1024; dst = (bf16_t*)(ws + WS_WOUT); srccol = ns * 256; }
        float4 v[8];
#pragma unroll
        for (int i = 0; i < 8; ++i) { const int idx = tid + 512 * i; const int k = idx >> 6, n4 = idx & 63; v[i] = *(const float4*)(src + (size_t)(kt * 64 + k) * ldn + srccol + 4 * n4); }
#pragma unroll
        for (int i = 0; i < 8; ++i) { const int idx = tid + 512 * i; const int k = idx >> 6, n4 = idx & 63;
            strip[k * 257 + 4 * n4 + 0] = v[i].x; strip[k * 257 + 4 * n4 + 1] = v[i].y; strip[k * 257 + 4 * n4 + 2] = v[i].z; strip[k * 257 + 4 * n4 + 3] = v[i].w; }
        __syncthreads();
#pragma unroll
        for (int j = 0; j < 4; ++j) { const int piece = tid + 512 * j; const int n = piece >> 3, kv = piece & 7; float f[8];
#pragma unroll
            for (int e = 0; e < 8; ++e) f[e] = strip[(kv * 8 + e) * 257 + n];
            *(u32x4*)(dst + (size_t)(ns * 256 + n) * Kdim + kt * 64 + kv * 8) = pack8(f); }
        __syncthreads();
    }
    __syncthreads();
    bf16_t* H = (bf16_t*)((unsigned char*)p.out + OUT_H);
    float* GATES = (float*)(ws + WS_GATES);
    const float bias_l = p.b_if[((lane >> 5) & 1) * 4 + ((lane >> 4) & 1) * 2 + ((lane >> 3) & 1)];
    for (int row0 = (bid * 8 + wid) * 2; row0 < T_TOK; row0 += G * 16) {
        float4 v[2][4];
#pragma unroll
        for (int rr = 0; rr < 2; ++rr)
#pragma unroll
            for (int i = 0; i < 4; ++i) v[rr][i] = ((const float4*)(p.x + (size_t)(row0 + rr) * 1024))[i * 64 + lane];
#pragma unroll
        for (int rr = 0; rr < 2; ++rr) {
            const int row = row0 + rr;
            float ss = 0.f;
#pragma unroll
            for (int i = 0; i < 4; ++i) ss += v[rr][i].x * v[rr][i].x + v[rr][i].y * v[rr][i].y + v[rr][i].z * v[rr][i].z + v[rr][i].w * v[rr][i].w;
            ss = wave_sum(ss);
            const float rstd = rsqrtf(ss * (1.0f / 1024.0f) + EPS);
            float g[8];
#pragma unroll
            for (int j = 0; j < 8; ++j) g[j] = 0.f;
#pragma unroll
            for (int i = 0; i < 4; ++i) {
                const float4 pw = ((const float4*)p.pre_w)[i * 64 + lane];
                float hv[4] = {v[rr][i].x * rstd * pw.x, v[rr][i].y * rstd * pw.y, v[rr][i].z * rstd * pw.z, v[rr][i].w * rstd * pw.w};
                u32x2 w; w.x = cvt_pk_bf16(hv[0], hv[1]); w.y = cvt_pk_bf16(hv[2], hv[3]);
                *(u32x2*)(H + (size_t)row * 1024 + (i * 64 + lane) * 4) = w;
#pragma unroll
                for (int e = 0; e < 4; ++e) {
                    const int k = (i * 64 + lane) * 4 + e;
                    const f32x4 wa = *(const LAS f32x4*)(WG + k * 8), wb = *(const LAS f32x4*)(WG + k * 8 + 4);
                    g[0] += hv[e] * wa[0]; g[1] += hv[e] * wa[1]; g[2] += hv[e] * wa[2]; g[3] += hv[e] * wa[3];
                    g[4] += hv[e] * wb[0]; g[5] += hv[e] * wb[1]; g[6] += hv[e] * wb[2]; g[7] += hv[e] * wb[3];
                }
            }
            const bool h32 = (lane & 32) != 0, h16 = (lane & 16) != 0, h8 = (lane & 8) != 0;
            float t4[4], t2[2];
#pragma unroll
            for (int j = 0; j < 4; ++j) { const float send = h32 ? g[j] : g[j + 4], keep = h32 ? g[j + 4] : g[j]; t4[j] = keep + __shfl_xor(send, 32); }
#pragma unroll
            for (int j = 0; j < 2; ++j) { const float send = h16 ? t4[j] : t4[j + 2], keep = h16 ? t4[j + 2] : t4[j]; t2[j] = keep + __shfl_xor(send, 16); }
            float gt; { const float send = h8 ? t2[0] : t2[1], keep = h8 ? t2[1] : t2[0]; gt = keep + __shfl_xor(send, 8); }
            gt += __shfl_xor(gt, 4); gt += __shfl_xor(gt, 2); gt += __shfl_xor(gt, 1);
            if ((lane & 7) == 0) {
                const int j = (h32 ? 4 : 0) + (h16 ? 2 : 0) + (h8 ? 1 : 0);
                const float gv = gt + bias_l;
                GATES[(size_t)row * 8 + j] = (j < 4) ? gv : (fminf(gv, 0.f) - log1pf(expf(-fabsf(gv))));
            }
        }
    }
    float* RC = (float*)(ws + WS_ROPE); float* RS = RC + 2048 * 16;
    for (int idx = bid * 512 + tid; idx < 2048 * 16; idx += G * 512) {
        const int pos = idx >> 4, i = idx & 15;
        const float inv = powf(500000.0f, -(float)(2 * i) / 32.0f);
        const float ang = (float)pos * inv;
        RC[idx] = cosf(ang); RS[idx] = sinf(ang);
    }
}

constexpr int ML_KB = 0, ML_VT = 67584, ML_WVT = 81920, ML_CT = 96256, ML_G = 124928;
constexpr int KB_STRIDE = 528, VR_STRIDE = 112;

__device__ __forceinline__ void p_conv(const Params& p) {
    const int tid = threadIdx.x;
    const bf16_t* R1 = (const bf16_t*)(p.ws + WS_R1); bf16_t* QK = (bf16_t*)(p.ws + WS_R2);
    const int dvec = tid & 31, rg = tid >> 5; const int s0 = rg * 8;
    for (int tile = blockIdx.x; tile < 1024; tile += gridDim.x) {
        const int cg8 = tile & 7, rt = tile >> 3;
        const int ch = cg8 * 256 + dvec * 8; const int tok0 = rt * 128; const int seq0 = (rt & 15) * 128;
        const float scale = (cg8 >= 4) ? 0.0625f : 1.0f;
        float cw[4][8], cb[8];
#pragma unroll
        for (int w = 0; w < 4; ++w) { const float4 a = *(const float4*)(p.conv_w + w * 2048 + ch), b = *(const float4*)(p.conv_w + w * 2048 + ch + 4);
            cw[w][0] = a.x; cw[w][1] = a.y; cw[w][2] = a.z; cw[w][3] = a.w; cw[w][4] = b.x; cw[w][5] = b.y; cw[w][6] = b.z; cw[w][7] = b.w; }
        { const float4 a = *(const float4*)(p.conv_b + ch), b = *(const float4*)(p.conv_b + ch + 4);
            cb[0] = a.x; cb[1] = a.y; cb[2] = a.z; cb[3] = a.w; cb[4] = b.x; cb[5] = b.y; cb[6] = b.z; cb[7] = b.w; }
        u32x4 raw[11];
#pragma unroll
        for (int i = 0; i < 11; ++i) {
            const int rr = s0 - 3 + i;
            if (seq0 + rr >= 0) raw[i] = *(const u32x4*)(R1 + (size_t)(tok0 + rr) * 5120 + ch); else raw[i] = (u32x4){0u, 0u, 0u, 0u};
        }
#pragma unroll
        for (int i = 0; i < 8; ++i) {
            float o[8];
#pragma unroll
            for (int e = 0; e < 8; ++e) o[e] = cb[e];
#pragma unroll
            for (int w = 0; w < 4; ++w) { float f[8]; unpack8(raw[i + w], f);
#pragma unroll
                for (int e = 0; e < 8; ++e) o[e] += cw[w][e] * f[e]; }
#pragma unroll
            for (int e = 0; e < 8; ++e) o[e] = siluf_(o[e]) * scale;
            st_wt16(QK + (size_t)(tok0 + s0 + i) * 2048 + ch, pack8(o));
        }
    }
}

__device__ __forceinline__ void p2_mlstm(const Params& p, LAS unsigned char* lds) {
    const int tid = threadIdx.x, wid = __builtin_amdgcn_readfirstlane(tid >> 6), lane = tid & 63, r = lane & 15, q = lane >> 4;
    unsigned char* ws = p.ws;
    const bf16_t* R1 = (const bf16_t*)(ws + WS_R1); const bf16_t* QK = (const bf16_t*)(ws + WS_R2);
    const float* GATES = (const float*)(ws + WS_GATES);
    float* SSQ = (float*)(ws + WS_SSQ);
    bf16_t* HM = (bf16_t*)((unsigned char*)p.out + OUT_HM);
    LAS unsigned char* KB = lds + ML_KB; LAS unsigned char* VT = lds + ML_VT; LAS unsigned char* CT = lds + ML_CT; LAS unsigned char* WVT = lds + ML_WVT;
    LAS unsigned char* NV = lds + 149760;
    LAS unsigned char* WV = lds + 150272;
    LAS float* PU = (LAS float*)(lds + ML_G); LAS float* PCM = PU + 2048; LAS float* PB = PU + 4096; LAS float* PBT = PU + 6144; LAS float* PCT = PBT + 16; LAS float* MPREV = PBT + 32; LAS float* MM127 = PBT + 48;
    for (int it = blockIdx.x; it < 256; it += gridDim.x) {
        const int xcd = it & 7, idx = it >> 3; const int bh = xcd * 4 + (idx >> 3), sl = idx & 7; const int b = bh >> 2, h = bh & 3;
        const int tokbase = b * SEQ;
        f32x4 cacc[3][2];
#pragma unroll
        for (int vt = 0; vt < 3; ++vt)
#pragma unroll
            for (int dd = 0; dd < 2; ++dd) cacc[vt][dd] = (f32x4){0.f, 0.f, 0.f, 0.f};
        for (int i = tid; i < (ML_G - ML_VT) / 4; i += 512) ((LAS unsigned*)(lds + ML_VT))[i] = 0u;
#pragma unroll 1
        for (int cc = 0; cc < 2; ++cc) {
            const int ck = 2 * wid + cc; const int t0 = tokbase + ck * 128 + 2 * lane;
            const float ig0 = GATES[(size_t)t0 * 8 + h], lf0 = GATES[(size_t)t0 * 8 + 4 + h], ig1 = GATES[(size_t)(t0 + 1) * 8 + h], lf1 = GATES[(size_t)(t0 + 1) * 8 + 4 + h];
            float sc = lf0 + lf1;
#pragma unroll
            for (int off = 1; off < 64; off <<= 1) { const float t = __shfl_up(sc, off); if (lane >= off) sc += t; }
            const float b1 = sc, b0 = sc - lf1;
            const float u0 = ig0 - b0, u1 = ig1 - b1;
            float cm = fmaxf(u0, u1);
#pragma unroll
            for (int off = 1; off < 64; off <<= 1) { const float t = __shfl_up(cm, off); if (lane >= off) cm = fmaxf(cm, t); }
            float cprev = __shfl_up(cm, 1); if (lane == 0) cprev = -1e30f;
            const int gi = ck * 128 + 2 * lane;
            PU[gi] = u0; PU[gi + 1] = u1; PCM[gi] = fmaxf(cprev, u0); PCM[gi + 1] = cm; PB[gi] = b0; PB[gi + 1] = b1;
            if (lane == 63) { PBT[ck] = b1; PCT[ck] = cm; }
        }
        __syncthreads();
        if (tid < 128) ((LAS unsigned*)NV)[tid] = 0u;
        if (tid == 0) {
            float mprev = 0.f;
#pragma unroll 1
            for (int c = 0; c < 16; ++c) { const float mm = fmaxf(mprev, PCT[c]); MPREV[c] = mprev; MM127[c] = mm; mprev = PBT[c] + mm; }
        }
        u32x4 kreg[8], vreg, qfn[8];
        const unsigned qoff = ((unsigned)(16 * wid + r) * 2048u + (unsigned)(h * 256 + 8 * q)) * 2u;
        const unsigned koff = ((unsigned)(tid >> 5) * 2048u + 1024u + (unsigned)(h * 256) + (unsigned)(tid & 31) * 8u) * 2u;
        const unsigned voff = ((unsigned)(tid >> 2) * 5120u + 2048u + (unsigned)(h * 256 + sl * 32) + (unsigned)(tid & 3) * 8u) * 2u;
        const unsigned ooff = ((unsigned)(16 * wid + r) * 5120u + 3072u + (unsigned)(h * 256 + sl * 32 + 4 * q)) * 2u;
        const unsigned hoff = ((unsigned)(16 * wid + r) * 1024u + (unsigned)(h * 256 + sl * 32 + 4 * q)) * 2u;
        {
            const bf16_t* qkc = QK + (size_t)tokbase * 2048; const bf16_t* r1c = R1 + (size_t)tokbase * 5120;
#pragma unroll
            for (int kk = 0; kk < 8; ++kk) qfn[kk] = ldg16(qkc, qoff + 64u * kk);
#pragma unroll
            for (int i = 0; i < 8; ++i) kreg[i] = ldg16(qkc, koff + 65536u * i);
            vreg = ldg16(r1c, voff);
        }
        __syncthreads();
        for (int chunk = 0; chunk < 16; ++chunk) {
            const int tok0 = tokbase + chunk * 128;
            bf16x8 qf[8];
            {
#pragma unroll
                for (int kk = 0; kk < 8; ++kk) qf[kk] = __builtin_bit_cast(bf16x8, qfn[kk]);
#pragma unroll
                for (int i = 0; i < 8; ++i) { const int vec = tid + 512 * i; *(LAS u32x4*)(KB + (vec >> 5) * KB_STRIDE + (vec & 31) * 16) = kreg[i]; }
                const int s = tid >> 2, vq = tid & 3;
                const float wgt = __expf(PU[chunk * 128 + s] - MM127[chunk]);
                float vf[8]; unpack8(vreg, vf);
#pragma unroll
                for (int e = 0; e < 8; ++e) vf[e] *= wgt;
                *(LAS u32x4*)(VT + s * VR_STRIDE + vq * 16) = vreg;
                *(LAS u32x4*)(WVT + s * VR_STRIDE + vq * 16) = pack8(vf);
                if (vq == 0) *(LAS bf16_t*)(WV + s * 2) = f2bf(wgt);
            }
            __syncthreads();
            u32x2 owr[2], zwr[2];
            {
                const bf16_t* r1c = R1 + (size_t)tok0 * 5120;
#pragma unroll
                for (int vt = 0; vt < 2; ++vt) { owr[vt] = ldg8(r1c, ooff + 32u * vt); zwr[vt] = ldg8(r1c, ooff + 2048u + 32u * vt); }
            }
            const int gl0 = chunk * 128;
            const float mprev = MPREV[chunk], mm127 = MM127[chunk];
            {
                const int l = 16 * wid + r;
                const float mml = fmaxf(mprev, PCM[gl0 + l]);
                f32x4 hacc[3];
                for (int mrep = 0; mrep < MLX2; ++mrep) {
#pragma unroll
                for (int vt = 0; vt < 3; ++vt) hacc[vt] = (f32x4){0.f, 0.f, 0.f, 0.f};
#pragma unroll
                for (int kh = 0; kh < 4; ++kh) {
                    bf16x8 af[2][3];
#pragma unroll
                    for (int k4 = 0; k4 < 2; ++k4)
                    {
#pragma unroll
                        for (int vt = 0; vt < 2; ++vt) {
                            const u32x2 lo = tr_read(CT + (32 * (2 * kh + k4) + 8 * q + (r >> 2)) * VR_STRIDE + (16 * vt + 4 * (r & 3)) * 2);
                            const u32x2 hi = tr_read(CT + (32 * (2 * kh + k4) + 8 * q + 4 + (r >> 2)) * VR_STRIDE + (16 * vt + 4 * (r & 3)) * 2);
                            u32x4 cw; cw.x = lo.x; cw.y = lo.y; cw.z = hi.x; cw.w = hi.y; af[k4][vt] = __builtin_bit_cast(bf16x8, cw);
                        }
                        u32x4 nz = (u32x4){0u, 0u, 0u, 0u};
                        if (r == 0) nz = *(const LAS u32x4*)(NV + (32 * (2 * kh + k4) + 8 * q) * 2);
                        af[k4][2] = __builtin_bit_cast(bf16x8, nz);
                    }
                    __builtin_amdgcn_sched_barrier(0);
#pragma unroll
                    for (int k4 = 0; k4 < 2; ++k4)
#pragma unroll
                        for (int vt = 0; vt < 3; ++vt) hacc[vt] = __builtin_amdgcn_mfma_f32_16x16x32_bf16(af[k4][vt], qf[2 * kh + k4], hacc[vt], 0, 0, 0);
                    __builtin_amdgcn_sched_barrier(0);
                }
                const float inter = __expf(mprev - mml);
#pragma unroll
                for (int vt = 0; vt < 3; ++vt) hacc[vt] *= inter;
                {
                    const int nb = 4 * ((wid >> 1) + 1);
                    bf16x8 fa0[2], fa1[2], fb0[2], fb1[2];
#define ML_LDB(d0, d1, bb) do { _Pragma("unroll") for (int k4 = 0; k4 < 2; ++k4) { \
                        d0[k4] = *(const LAS bf16x8*)(KB + (32 * ((bb) >> 2) + r) * KB_STRIDE + (32 * (2 * ((bb) & 3) + k4) + 8 * q) * 2); \
                        d1[k4] = *(const LAS bf16x8*)(KB + (32 * ((bb) >> 2) + 16 + r) * KB_STRIDE + (32 * (2 * ((bb) & 3) + k4) + 8 * q) * 2); } } while (0)
                    ML_LDB(fa0, fa1, 0);
                    f32x4 s0 = (f32x4){0.f, 0.f, 0.f, 0.f}, s1 = s0;
#pragma unroll
                    for (int bb = 0; bb < 16; ++bb) {
                        if (bb < nb) {
                            if (bb + 1 < nb) { if (bb & 1) ML_LDB(fa0, fa1, bb + 1); else ML_LDB(fb0, fb1, bb + 1); }
                            __builtin_amdgcn_sched_barrier(0);
#pragma unroll
                            for (int k4 = 0; k4 < 2; ++k4) {
                                s0 = __builtin_amdgcn_mfma_f32_16x16x32_bf16((bb & 1) ? fb0[k4] : fa0[k4], qf[2 * (bb & 3) + k4], s0, 0, 0, 0);
                                s1 = __builtin_amdgcn_mfma_f32_16x16x32_bf16((bb & 1) ? fb1[k4] : fa1[k4], qf[2 * (bb & 3) + k4], s1, 0, 0, 0);
                            }
                            __builtin_amdgcn_sched_barrier(0);
                            if ((bb & 3) == 3) {
                                const int sp = bb >> 2;
                                const f32x4 u0 = *(const LAS f32x4*)(PU + gl0 + 32 * sp + 4 * q), u1 = *(const LAS f32x4*)(PU + gl0 + 32 * sp + 16 + 4 * q);
                                if (2 * sp < wid) {
#pragma unroll
                                    for (int j = 0; j < 4; ++j) s0[j] *= __expf(u0[j] - mml);
                                } else {
#pragma unroll
                                    for (int j = 0; j < 4; ++j) s0[j] = (4 * q + j <= r) ? s0[j] * __expf(u0[j] - mml) : 0.f;
                                }
                                if (2 * sp + 1 < wid) {
#pragma unroll
                                    for (int j = 0; j < 4; ++j) s1[j] *= __expf(u1[j] - mml);
                                } else if (2 * sp + 1 == wid) {
#pragma unroll
                                    for (int j = 0; j < 4; ++j) s1[j] = (4 * q + j <= r) ? s1[j] * __expf(u1[j] - mml) : 0.f;
                                } else {
                                    s1 = (f32x4){0.f, 0.f, 0.f, 0.f};
                                }
                                u32x4 bw; bw.x = cvt_pk_bf16(s0[0], s0[1]); bw.y = cvt_pk_bf16(s0[2], s0[3]); bw.z = cvt_pk_bf16(s1[0], s1[1]); bw.w = cvt_pk_bf16(s1[2], s1[3]);
                                const bf16x8 bfrag = __builtin_bit_cast(bf16x8, bw);
#pragma unroll
                                for (int vt = 0; vt < 2; ++vt) {
                                    const u32x2 lo = tr_read(VT + (32 * sp + 4 * q + (r >> 2)) * VR_STRIDE + (16 * vt + 4 * (r & 3)) * 2);
                                    const u32x2 hi = tr_read(VT + (32 * sp + 16 + 4 * q + (r >> 2)) * VR_STRIDE + (16 * vt + 4 * (r & 3)) * 2);
                                    u32x4 aw; aw.x = lo.x; aw.y = lo.y; aw.z = hi.x; aw.w = hi.y;
                                    hacc[vt] = __builtin_amdgcn_mfma_f32_16x16x32_bf16(__builtin_bit_cast(bf16x8, aw), bfrag, hacc[vt], 0, 0, 0);
                                }
                                { const unsigned one2 = (r == 0) ? 0x3F803F80u : 0u; const u32x4 ow = (u32x4){one2, one2, one2, one2};
                                  hacc[2] = __builtin_amdgcn_mfma_f32_16x16x32_bf16(__builtin_bit_cast(bf16x8, ow), bfrag, hacc[2], 0, 0, 0); }
                                s0 = (f32x4){0.f, 0.f, 0.f, 0.f}; s1 = s0;
                            }
                        }
                    }
#undef ML_LDB
                }
                }
                const float den = __shfl(hacc[2][0], r);
                const float dn = fmaxf(fabsf(den), __expf(-(PB[gl0 + l] + mml)));
                const float rdn = 1.0f / dn;
                const int t = tok0 + l;
                float ssq = 0.f;
#pragma unroll
                for (int vt = 0; vt < 2; ++vt) {
                    const int c = h * 256 + sl * 32 + 16 * vt + 4 * q;
                    const u32x2 ow = owr[vt], zw = zwr[vt];
                    const float4 nw = *(const float4*)(p.m_norm_w + c);
                    const float og[4] = {bflo(ow.x), bfhi(ow.x), bflo(ow.y), bfhi(ow.y)};
                    const float zg[4] = {bflo(zw.x), bfhi(zw.x), bflo(zw.y), bfhi(zw.y)};
                    const float nwv[4] = {nw.x, nw.y, nw.z, nw.w};
                    float uo[4];
#pragma unroll
                    for (int j = 0; j < 4; ++j) { const float hs = hacc[vt][j] * rdn * sigmoidf_(og[j]); ssq += hs * hs; uo[j] = hs * nwv[j] * siluf_(zg[j]); }
                    u32x2 w; w.x = cvt_pk_bf16(uo[0], uo[1]); w.y = cvt_pk_bf16(uo[2], uo[3]);
                    stg8(HM + (size_t)tok0 * 1024, hoff + 32u * vt, w);
                }
                ssq += __shfl_xor(ssq, 16); ssq += __shfl_xor(ssq, 32);
                if (q == 0) SSQ[((size_t)t * 4 + h) * 8 + sl] = ssq;
                if (chunk < 15) {
                    const bf16_t* qkc = QK + (size_t)(tok0 + 128) * 2048; const bf16_t* r1c = R1 + (size_t)(tok0 + 128) * 5120;
#pragma unroll
                    for (int kk = 0; kk < 8; ++kk) qfn[kk] = ldg16(qkc, qoff + 64u * kk);
#pragma unroll
                    for (int i = 0; i < 8; ++i) kreg[i] = ldg16(qkc, koff + 65536u * i);
                    vreg = ldg16(r1c, voff);
                }

                const float decay = __expf(mprev - mm127);
#pragma unroll
                for (int vt = 0; vt < 3; ++vt)
#pragma unroll
                    for (int dd = 0; dd < 2; ++dd) cacc[vt][dd] *= decay;
#pragma unroll
                for (int kk = 0; kk < 4; ++kk) {
                    bf16x8 kb[2], wa[3];
#pragma unroll
                    for (int dd = 0; dd < 2; ++dd) {
                        const u32x2 lo = tr_read(KB + (32 * kk + 8 * q + (r >> 2)) * KB_STRIDE + (16 * (2 * wid + dd) + 4 * (r & 3)) * 2);
                        const u32x2 hi = tr_read(KB + (32 * kk + 8 * q + 4 + (r >> 2)) * KB_STRIDE + (16 * (2 * wid + dd) + 4 * (r & 3)) * 2);
                        u32x4 kw; kw.x = lo.x; kw.y = lo.y; kw.z = hi.x; kw.w = hi.y; kb[dd] = __builtin_bit_cast(bf16x8, kw);
                    }
#pragma unroll
                    for (int vt = 0; vt < 2; ++vt) {
                        const u32x2 lo = tr_read(WVT + (32 * kk + 8 * q + (r >> 2)) * VR_STRIDE + (16 * vt + 4 * (r & 3)) * 2);
                        const u32x2 hi = tr_read(WVT + (32 * kk + 8 * q + 4 + (r >> 2)) * VR_STRIDE + (16 * vt + 4 * (r & 3)) * 2);
                        u32x4 ww; ww.x = lo.x; ww.y = lo.y; ww.z = hi.x; ww.w = hi.y; wa[vt] = __builtin_bit_cast(bf16x8, ww);
                    }
                    { u32x4 wz = (u32x4){0u, 0u, 0u, 0u}; if (r == 0) wz = *(const LAS u32x4*)(WV + (32 * kk + 8 * q) * 2); wa[2] = __builtin_bit_cast(bf16x8, wz); }
                    __builtin_amdgcn_sched_barrier(0);
#pragma unroll
                    for (int vt = 0; vt < 3; ++vt)
#pragma unroll
                        for (int dd = 0; dd < 2; ++dd) cacc[vt][dd] = __builtin_amdgcn_mfma_f32_16x16x32_bf16(wa[vt], kb[dd], cacc[vt][dd], 0, 0, 0);
                    __builtin_amdgcn_sched_barrier(0);
                }
            }
            __syncthreads();
#pragma unroll
            for (int vt = 0; vt < 2; ++vt)
#pragma unroll
                for (int dd = 0; dd < 2; ++dd)
                    { u32x2 cw; cw.x = cvt_pk_bf16(cacc[vt][dd][0], cacc[vt][dd][1]); cw.y = cvt_pk_bf16(cacc[vt][dd][2], cacc[vt][dd][3]);
                      *(LAS u32x2*)(CT + (16 * (2 * wid + dd) + r) * VR_STRIDE + (16 * vt + 4 * q) * 2) = cw; }
            if (q == 0) {
#pragma unroll
                for (int dd = 0; dd < 2; ++dd) *(LAS bf16_t*)(NV + (16 * (2 * wid + dd) + r) * 2) = f2bf(cacc[2][dd][0]);
            }
        }
        __syncthreads();
    }
}

constexpr int AT_KA = 0, AT_VB = 69632;
constexpr int KA_STRIDE = 272, VB_STRIDE = 288;
struct AttnItem { int b, g, hh, blk, rr, dil; };
__device__ __forceinline__ AttnItem attn_item(int it) {
    AttnItem a; const int sub = it & 15; a.hh = (it >> 4) & 3; a.g = (it >> 6) % 3; a.b = it / 192;
    const int lg = 2 * a.g; a.dil = 1 << lg; const int nblk = 16 >> lg; a.blk = sub & (nblk - 1); a.rr = sub >> (4 - lg); return a;
}
__device__ __forceinline__ void attn_load(const bf16_t* R1, const AttnItem& a, int tid, u32x4 (&kr)[8], u32x4 (&vr)[8]) {
    const int lg = 2 * a.g;
    const size_t seq = (size_t)a.g * ((size_t)T_TOK * 512) + (size_t)((((a.b * 4 + a.hh) << lg) + a.rr) * (2048 >> lg)) * 128;
    const bf16_t* Kq = (const bf16_t*)((const unsigned char*)R1 + R1_KA) + seq; const bf16_t* Vq = (const bf16_t*)((const unsigned char*)R1 + R1_VA) + seq;
    const int row = tid >> 1, pv = tid & 1; const int jk = a.blk * 128 - 128 + row;
    const u32x4 z = (u32x4){0u, 0u, 0u, 0u};
    if (jk >= 0) { const bf16_t* src = Kq + (size_t)jk * 128; kr[0] = *(const u32x4*)(src + 8 * pv); kr[1] = *(const u32x4*)(src + 16 + 8 * pv); } else { kr[0] = z; kr[1] = z; }
#pragma unroll
    for (int i = 0; i < 6; ++i) {
        const int task = tid + 512 * i; const int row2 = task / 12, v = 4 + task % 12; const int jk2 = a.blk * 128 - 128 + row2;
        kr[2 + i] = (jk2 >= 0) ? *(const u32x4*)(Kq + (size_t)jk2 * 128 + v * 8) : z;
    }
#pragma unroll
    for (int vi = 0; vi < 8; ++vi) vr[vi] = (jk >= 0) ? *(const u32x4*)(Vq + (size_t)jk * 128 + pv * 64 + vi * 8) : z;
}
__device__ __forceinline__ void p4_attn(const Params& p, LAS unsigned char* lds, const int dummy) {
    const int tid = threadIdx.x, wid = __builtin_amdgcn_readfirstlane(tid >> 6), lane = tid & 63, r = lane & 15, q = lane >> 4;
    unsigned char* ws = p.ws;
    bf16_t* R1 = (bf16_t*)(ws + WS_R1);
    const float* RC = (const float*)(ws + WS_ROPE); const float* RS = RC + 2048 * 16;
    float* ML = (float*)((unsigned char*)p.out + OUT_ML);
    LAS unsigned char* KA = lds + AT_KA; LAS unsigned char* VB = lds + AT_VB;
    const float QSCALE = 0.08838834764831845f * 1.4426950408889634f;
    u32x4 kr[8], vr[8];
    int it = blockIdx.x;
    if (it < 1536) { const AttnItem a0 = attn_item(it); attn_load(R1, a0, tid, kr, vr); }
    for (; it < 1536; it += gridDim.x) {
        const AttnItem a = attn_item(it);
        const int blk = a.blk, dil = a.dil, rr = a.rr, g = a.g, hh = a.hh;
        const int tokb = a.b * SEQ; const int qcol = g * 512 + hh * 128;
        {
            const int row = tid >> 1, pv = tid & 1; const int jk = blk * 128 - 128 + row;
            u32x4 o1 = kr[0], o2 = kr[1];
            if (jk >= 0) {
                const int pos = jk * dil + rr;
                float x1[8], x2[8]; unpack8(kr[0], x1); unpack8(kr[1], x2);
                const float4 ca = *(const float4*)(RC + pos * 16 + 8 * pv), cb = *(const float4*)(RC + pos * 16 + 8 * pv + 4);
                const float4 sa = *(const float4*)(RS + pos * 16 + 8 * pv), sb = *(const float4*)(RS + pos * 16 + 8 * pv + 4);
                const float cc[8] = {ca.x, ca.y, ca.z, ca.w, cb.x, cb.y, cb.z, cb.w}, sn[8] = {sa.x, sa.y, sa.z, sa.w, sb.x, sb.y, sb.z, sb.w};
                float y1[8], y2[8];
#pragma unroll
                for (int e = 0; e < 8; ++e) { y1[e] = x1[e] * cc[e] - x2[e] * sn[e]; y2[e] = x2[e] * cc[e] + x1[e] * sn[e]; }
                o1 = pack8(y1); o2 = pack8(y2);
            }
            *(LAS u32x4*)(KA + row * KA_STRIDE + (8 * pv) * 2) = o1;
            *(LAS u32x4*)(KA + row * KA_STRIDE + (16 + 8 * pv) * 2) = o2;
#pragma unroll
            for (int i = 0; i < 6; ++i) { const int task = tid + 512 * i; const int row2 = task / 12, v = 4 + task % 12; *(LAS u32x4*)(KA + row2 * KA_STRIDE + v * 16) = kr[2 + i]; }
#pragma unroll
            for (int vi = 0; vi < 8; ++vi) *(LAS u32x4*)(VB + row * VB_STRIDE + (pv * 64 + vi * 8) * 2) = vr[vi];
        }
        const int ql = 16 * wid + r; const int jq = blk * 128 + ql; const int posq = jq * dil + rr; const size_t tq = (size_t)(tokb + posq);
        bf16x8 qf[4];
        {
            bf16_t* qsrc = R1 + tq * QZ_LD + qcol;
#pragma unroll
            for (int kk = 0; kk < 4; ++kk) {
                const u32x4 av = *(const u32x4*)(qsrc + 32 * kk + 8 * q);
                float x[8]; unpack8(av, x);
                if (kk == 0) {
                    const int fi = 8 * (q & 1);
                    const float4 ca = *(const float4*)(RC + posq * 16 + fi), cb = *(const float4*)(RC + posq * 16 + fi + 4);
                    const float4 sa = *(const float4*)(RS + posq * 16 + fi), sb = *(const float4*)(RS + posq * 16 + fi + 4);
                    const float cc[8] = {ca.x, ca.y, ca.z, ca.w, cb.x, cb.y, cb.z, cb.w}, sn[8] = {sa.x, sa.y, sa.z, sa.w, sb.x, sb.y, sb.z, sb.w};
#pragma unroll
                    for (int e = 0; e < 8; ++e) { const float xo = __shfl_xor(x[e], 32); x[e] = (q < 2) ? (x[e] * cc[e] - xo * sn[e]) : (x[e] * cc[e] + xo * sn[e]); }
                }
#pragma unroll
                for (int e = 0; e < 8; ++e) x[e] *= QSCALE;
                qf[kk] = __builtin_bit_cast(bf16x8, pack8(x));
            }
        }
        __syncthreads();
        if (it + (int)gridDim.x < 1536) { const AttnItem an = attn_item(it + gridDim.x); attn_load(R1, an, tid, kr, vr); }
        const int ilo = (blk == 0) ? 8 - wid : 0;
        f32x4 sT[9];
#pragma unroll
        for (int i = 0; i < 9; ++i) sT[i] = (f32x4){0.f, 0.f, 0.f, 0.f};
#pragma unroll
        for (int gi = 0; gi < 3; ++gi) {
            if (3 * gi + 2 >= ilo) {
                bf16x8 ka[3][4];
#pragma unroll
                for (int i3 = 0; i3 < 3; ++i3)
#pragma unroll
                    for (int kk = 0; kk < 4; ++kk) ka[i3][kk] = *(const LAS bf16x8*)(KA + (16 * (wid + 3 * gi + i3) + r) * KA_STRIDE + (32 * kk + 8 * q) * 2);
                __builtin_amdgcn_sched_barrier(0);
#pragma unroll
                for (int kk = 0; kk < 4; ++kk)
#pragma unroll
                    for (int i3 = 0; i3 < 3; ++i3) sT[3 * gi + i3] = __builtin_amdgcn_mfma_f32_16x16x32_bf16(ka[i3][kk], qf[kk], sT[3 * gi + i3], 0, 0, 0);
                __builtin_amdgcn_sched_barrier(0);
            }
        }
        float mx = -1e30f;
#pragma unroll
        for (int i = 0; i < 9; ++i)
#pragma unroll
            for (int j = 0; j < 4; ++j) {
                const int kl = 16 * (wid + i) + 4 * q + j; const int dist = ql - kl + 128; const int jk = blk * 128 - 128 + kl;
                const bool valid = (dist >= 0) && (dist <= 128) && (jk >= 0);
                sT[i][j] = valid ? sT[i][j] : -1e30f; mx = fmaxf(mx, sT[i][j]);
            }
        mx = fmaxf(mx, __shfl_xor(mx, 16)); mx = fmaxf(mx, __shfl_xor(mx, 32));
        float lsum = 0.f;
#pragma unroll
        for (int i = 0; i < 9; ++i)
#pragma unroll
            for (int j = 0; j < 4; ++j) { const float pe = (sT[i][j] > -1e29f) ? exp2f(sT[i][j] - mx) : 0.f; sT[i][j] = pe; lsum += pe; }
        lsum += __shfl_xor(lsum, 16); lsum += __shfl_xor(lsum, 32);
        f32x4 oacc[8];
#pragma unroll
        for (int et = 0; et < 8; ++et) oacc[et] = (f32x4){0.f, 0.f, 0.f, 0.f};
#pragma unroll
        for (int ps = 0; ps < 5; ++ps) {
            if (2 * ps + 1 >= ilo) {
                u32x4 bw; bw.x = cvt_pk_bf16(sT[2 * ps][0], sT[2 * ps][1]); bw.y = cvt_pk_bf16(sT[2 * ps][2], sT[2 * ps][3]);
                if (ps < 4) { bw.z = cvt_pk_bf16(sT[(2 * ps + 1) % 9][0], sT[(2 * ps + 1) % 9][1]); bw.w = cvt_pk_bf16(sT[(2 * ps + 1) % 9][2], sT[(2 * ps + 1) % 9][3]); } else { bw.z = 0u; bw.w = 0u; }
                const bf16x8 bfrag = __builtin_bit_cast(bf16x8, bw);
                u32x2 vlo[8], vhi[8];
#pragma unroll
                for (int et = 0; et < 8; ++et) {
                    vlo[et] = tr_read(VB + (16 * (wid + 2 * ps) + 4 * q + (r >> 2)) * VB_STRIDE + (16 * et + 4 * (r & 3)) * 2);
                    vhi[et] = (u32x2){0u, 0u};
                    if (ps < 4) vhi[et] = tr_read(VB + (16 * (wid + 2 * ps + 1) + 4 * q + (r >> 2)) * VB_STRIDE + (16 * et + 4 * (r & 3)) * 2);
                }
                __builtin_amdgcn_sched_barrier(0);
#pragma unroll
                for (int et = 0; et < 8; ++et) {
                    u32x4 aw; aw.x = vlo[et].x; aw.y = vlo[et].y; aw.z = vhi[et].x; aw.w = vhi[et].y;
                    oacc[et] = __builtin_amdgcn_mfma_f32_16x16x32_bf16(__builtin_bit_cast(bf16x8, aw), bfrag, oacc[et], 0, 0, 0);
                }
                __builtin_amdgcn_sched_barrier(0);
            }
        }
        const float rl = 1.0f / lsum;
        {
            bf16_t* odst = dummy ? (bf16_t*)((unsigned char*)p.out + 8388608 + ((tq * 1536 + qcol) * 2 & 16777215)) : R1 + tq * QZ_LD + qcol;
            const bool oddq = (q & 1) != 0;
#pragma unroll
            for (int pp = 0; pp < 4; ++pp) {
                u32x2 wa, wb;
                wa.x = cvt_pk_bf16(oacc[2 * pp][0] * rl, oacc[2 * pp][1] * rl); wa.y = cvt_pk_bf16(oacc[2 * pp][2] * rl, oacc[2 * pp][3] * rl);
                wb.x = cvt_pk_bf16(oacc[2 * pp + 1][0] * rl, oacc[2 * pp + 1][1] * rl); wb.y = cvt_pk_bf16(oacc[2 * pp + 1][2] * rl, oacc[2 * pp + 1][3] * rl);
                const unsigned sx = oddq ? wa.x : wb.x, sy = oddq ? wa.y : wb.y;
                const unsigned rx = (unsigned)__shfl_xor((int)sx, 16), ry = (unsigned)__shfl_xor((int)sy, 16);
                const unsigned kx = oddq ? wb.x : wa.x, ky = oddq ? wb.y : wa.y;
                u32x4 v; v.x = oddq ? rx : kx; v.y = oddq ? ry : ky; v.z = oddq ? kx : rx; v.w = oddq ? ky : ry;
                const int e0 = oddq ? 16 * (2 * pp + 1) + 4 * (q - 1) : 16 * (2 * pp) + 4 * q;
                st_wt16(odst + e0, v);
            }
            if (q == 0) { float2 mlv; mlv.x = mx; mlv.y = lsum; *(float2*)(ML + (tq * 12 + g * 4 + hh) * 2) = mlv; }
        }
        __syncthreads();
    }
}

__device__ __forceinline__ void p5_fixup(const Params& p) {
    const int tid = threadIdx.x, G = gridDim.x, bid = blockIdx.x;
    unsigned char* ws = p.ws;
    const bf16_t* R1 = (const bf16_t*)(ws + WS_R1);
    const float* SSQ = (const float*)(ws + WS_SSQ);
    bf16_t* HM = (bf16_t*)((unsigned char*)p.out + OUT_HM);
    const float* ML = (const float*)((unsigned char*)p.out + OUT_ML);
    bf16_t* ATT = (bf16_t*)((unsigned char*)p.out + OUT_ATT);
    const int gtid = bid * 512 + tid, gsz = G * 512;
    for (int v0 = gtid; v0 < T_TOK * 128; v0 += 4 * gsz) {
        u32x4 hv[4]; float4 s0[4], s1[4];
#pragma unroll
        for (int u = 0; u < 4; ++u) { const int v = v0 + u * gsz; if (v < T_TOK * 128) { const int row = v >> 7, head = (v >> 5) & 3;
            hv[u] = *(const u32x4*)(HM + (size_t)v * 8); s0[u] = *(const float4*)(SSQ + ((size_t)row * 4 + head) * 8); s1[u] = *(const float4*)(SSQ + ((size_t)row * 4 + head) * 8 + 4); } }
#pragma unroll
        for (int u = 0; u < 4; ++u) { const int v = v0 + u * gsz; if (v < T_TOK * 128) {
            const float ss = (s0[u].x + s0[u].y) + (s0[u].z + s0[u].w) + (s1[u].x + s1[u].y) + (s1[u].z + s1[u].w);
            const float rstd = rsqrtf(ss * (1.0f / 256.0f) + EPS);
            float f[8]; unpack8(hv[u], f);
#pragma unroll
            for (int e = 0; e < 8; ++e) f[e] *= rstd;
            st_wt16(HM + (size_t)v * 8, pack8(f)); } }
    }
    for (int v0 = gtid; v0 < T_TOK * 64; v0 += 2 * gsz) {
        u32x4 ov[2][3], zv[2]; float2 ml[2][3];
#pragma unroll
        for (int u = 0; u < 2; ++u) { const int v = v0 + u * gsz; if (v < T_TOK * 64) { const int row = v >> 6, cv = v & 63, hs = cv >> 4;
#pragma unroll
            for (int g = 0; g < 3; ++g) { ml[u][g] = *(const float2*)(ML + ((size_t)row * 12 + g * 4 + hs) * 2); ov[u][g] = *(const u32x4*)(R1 + (size_t)row * QZ_LD + g * 512 + cv * 8); }
            zv[u] = *(const u32x4*)(R1 + (size_t)row * QZ_LD + 1536 + cv * 8); } }
#pragma unroll
        for (int u = 0; u < 2; ++u) { const int v = v0 + u * gsz; if (v < T_TOK * 64) {
            const float M = fmaxf(ml[u][0].x, fmaxf(ml[u][1].x, ml[u][2].x));
            float wt[3], W = 0.f;
#pragma unroll
            for (int g = 0; g < 3; ++g) { wt[g] = exp2f(ml[u][g].x - M) * ml[u][g].y; W += wt[g]; }
            const float rW = 1.0f / W;
            float acc[8];
#pragma unroll
            for (int e = 0; e < 8; ++e) acc[e] = 0.f;
#pragma unroll
            for (int g = 0; g < 3; ++g) { float f[8]; unpack8(ov[u][g], f);
#pragma unroll
                for (int e = 0; e < 8; ++e) acc[e] += wt[g] * f[e]; }
            float z[8]; unpack8(zv[u], z);
#pragma unroll
            for (int e = 0; e < 8; ++e) acc[e] = acc[e] * rW * siluf_(z[e]);
            st_wt16(ATT + (size_t)v * 8, pack8(acc)); } }
    }
}

__device__ __forceinline__ void p8_final(const Params& p) {
    const int tid = threadIdx.x, G = gridDim.x, bid = blockIdx.x, lane = tid & 63, wid = tid >> 6;
    const float* Y = (const float*)(p.ws + WS_R1 + R1_Y);
    for (int row = bid * 8 + wid; row < T_TOK; row += G * 8) {
        const float4* yr = (const float4*)(Y + (size_t)row * 1024); const float4* xr = (const float4*)(p.x + (size_t)row * 1024);
        float4 v[4]; float ss = 0.f;
#pragma unroll
        for (int i = 0; i < 4; ++i) { v[i] = yr[i * 64 + lane]; ss += v[i].x * v[i].x + v[i].y * v[i].y + v[i].z * v[i].z + v[i].w * v[i].w; }
        ss = wave_sum(ss);
        const float rstd = rsqrtf(ss * (1.0f / 1024.0f) + EPS);
#pragma unroll
        for (int i = 0; i < 4; ++i) {
            const float4 pw = ((const float4*)p.post_w)[i * 64 + lane]; const float4 xv = xr[i * 64 + lane];
            float4 o; o.x = xv.x + v[i].x * rstd * pw.x; o.y = xv.y + v[i].y * rstd * pw.y; o.z = xv.z + v[i].z * rstd * pw.z; o.w = xv.w + v[i].w * rstd * pw.w;
            ((float4*)(p.out + (size_t)row * 1024))[i * 64 + lane] = o;
        }
    }
}

__global__ void __launch_bounds__(512, 2) mega_fwd(Params p) {
    extern __shared__ __attribute__((aligned(16))) unsigned char lds_raw[];
    LAS unsigned char* lds = (LAS unsigned char*)lds_raw;
    cg::grid_group grid = cg::this_grid();
    const int lo = p.ph_lo, hi = p.ph_hi;
    unsigned char* ws = p.ws;
    const int G = gridDim.x, bid = blockIdx.x;
#define IN(k) (lo <= (k) && (k) < hi)
    if (threadIdx.x == 0) { ((volatile LAS unsigned*)(lds + LDS_BAR_OFF))[0] = 0u; ((volatile LAS unsigned*)(lds + LDS_BAR_OFF))[1] = 0u; }
    __syncthreads();
    XcdBarrier xbar; xbar.bar = (unsigned*)(ws + WS_BAR); xbar.x = 0; xbar.st = nullptr;
    if (hi - lo > 1) xbar = xcd_barrier_post((unsigned*)(ws + WS_BAR), (volatile LAS unsigned*)(lds + LDS_BAR_OFF));
#define SEAM(k) do { if (IN(k) && IN((k) + 1)) { xcd_barrier(xbar); if (REPB > 1) xcd_barrier(xbar); } } while (0)
    if (lo > 1000) grid.sync();
    bf16_t* H = (bf16_t*)((unsigned char*)p.out + OUT_H);
    bf16_t* HM = (bf16_t*)((unsigned char*)p.out + OUT_HM);
    bf16_t* ATT = (bf16_t*)((unsigned char*)p.out + OUT_ATT);
    bf16_t* WinT = (bf16_t*)(ws + WS_WIN);
    bf16_t* R1 = (bf16_t*)(ws + WS_R1); bf16_t* R2 = (bf16_t*)(ws + WS_R2);
    if (IN(0)) { for (int rep = 0; rep < REP0; ++rep) p0_prep(p, lds); }
    SEAM(0);
    if (IN(1)) {
        pg8::Gemm g{H, WinT, T_TOK, 5120, 1024}; pg8::StaticOrder S; S.init(T_TOK, 5120, G, bid);
        EpiStoreBf16 E{R1, 5120, 1 << 30, R1, 5120};
        for (int rep = 0; rep < REP1; ++rep) pg8::gemm_phase<EpiStoreBf16>(lds, g, S, E);
    }
    SEAM(1);
    if (IN(2)) { for (int rep = 0; rep < REPC; ++rep) p_conv(p); }
    SEAM(2);
    if (IN(3)) { for (int rep = 0; rep < REP2; ++rep) p2_mlstm(p, lds); }
    SEAM(3);
    if (IN(4)) {
        pg8::Gemm g{H, WinT + (size_t)5120 * 1024, T_TOK, 7168, 1024}; pg8::StaticOrder S; S.init(T_TOK, 7168, G, bid);
        EpiProjB E{R1, (bf16_t*)(ws + WS_R1 + R1_KA), (bf16_t*)(ws + WS_R1 + R1_VA), R2};
        for (int rep = 0; rep < REP4; ++rep) pg8::gemm_phase<EpiProjB>(lds, g, S, E);
    }
    SEAM(4);
    if (IN(5)) { for (int rep = 0; rep < REPA; ++rep) p4_attn(p, lds, rep < REPA - 1); }
    SEAM(5);
    if (IN(6)) { p5_fixup(p); }
    SEAM(6);
    if (IN(7)) {
        bf16_t* MG = (bf16_t*)(ws + WS_R1 + R1_MG);
        pg8::Gemm g0{HM, (const bf16_t*)(ws + WS_WPM), T_TOK, 1024, 1024}; pg8::Gemm g1{ATT, (const bf16_t*)(ws + WS_WPA), T_TOK, 1024, 512};
        pg8::StaticOrder S; S.init(T_TOK, 1024, G, bid);
        EpiRatio E0{R2}; EpiMerge2 E1{R2, MG};
        pg8::gemm_phase2<EpiRatio, EpiMerge2>(lds, g0, g1, S, E0, E1);
    }
    SEAM(7);
    const bool fuse_out = (G == 256);
    if (IN(8)) {
        pg8::Gemm g{(const bf16_t*)(ws + WS_R1 + R1_MG), (const bf16_t*)(ws + WS_WOUT), T_TOK, 1024, 1024}; pg8::StaticOrder S; S.init(T_TOK, 1024, G, bid);
        if (fuse_out) { EpiRmsRes E{p.x, p.post_w, p.out, (float*)(ws + WS_R2), (unsigned*)(ws + WS_BAR) + 3600}; pg8::gemm_phase<EpiRmsRes, true>(lds, g, S, E); }
        else { EpiF32 E{(float*)(ws + WS_R1 + R1_Y)}; pg8::gemm_phase<EpiF32>(lds, g, S, E); }
    }
    if (!fuse_out) {
        SEAM(8);
        if (IN(9)) { for (int rep = 0; rep < REP8; ++rep) p8_final(p); }
    }
}

extern "C" void kernel_launch(void* const* d_in, const int* in_sizes, int n_in, void* d_out, int out_size, void* d_ws, size_t ws_size, hipStream_t stream) {
    static int grid = 0;
    if (grid == 0) {
        int dev = 0, cus = 0, per_cu = 0;
        (void)hipGetDevice(&dev);
        (void)hipDeviceGetAttribute(&cus, hipDeviceAttributeMultiprocessorCount, dev);
        (void)hipFuncSetAttribute((const void*)mega_fwd, hipFuncAttributeMaxDynamicSharedMemorySize, LDS_BYTES);
        (void)hipOccupancyMaxActiveBlocksPerMultiprocessor(&per_cu, (const void*)mega_fwd, 512, LDS_BYTES);
        (void)hipGetLastError();
        if (per_cu < 1) per_cu = 1;
        if (per_cu > 1) per_cu = 1;
        grid = cus * per_cu;
        if (ws_size < WS_END) fprintf(stderr, "kernel_launch: workspace too small: %zu < %zu\n", ws_size, (size_t)WS_END);
    }
    Params p{};
    p.x = (const float*)d_in[0]; p.pre_w = (const float*)d_in[1]; p.w_in = (const float*)d_in[2]; p.b_if = (const float*)d_in[3];
    p.conv_w = (const float*)d_in[4]; p.conv_b = (const float*)d_in[5]; p.m_norm_w = (const float*)d_in[6]; p.w_pm = (const float*)d_in[7];
    p.w_pa = (const float*)d_in[8]; p.w_out = (const float*)d_in[9]; p.post_w = (const float*)d_in[10];
    p.out = (float*)d_out; p.ws = (unsigned char*)d_ws; p.ph_lo = 0; p.ph_hi = 10;
    (void)hipMemsetAsync((unsigned char*)d_ws + WS_BAR, 0, 16384, stream);
    void* args[] = {&p};
    hipError_t e = hipLaunchCooperativeKernel((const void*)mega_fwd, dim3(grid), dim3(512), args, LDS_BYTES, stream);
    if (e != hipSuccess) fprintf(stderr, "cooperative launch failed: %s (grid %d)\n", hipGetErrorString(e), grid);
}
```

```cpp
#include <hip/hip_runtime.h>
#include <hip/hip_cooperative_groups.h>
#include <cstdio>
namespace cg = cooperative_groups;

#define LAS __attribute__((address_space(3)))
typedef unsigned short bf16_t;
typedef short bf16x8 __attribute__((ext_vector_type(8)));
typedef float f32x4 __attribute__((ext_vector_type(4)));
typedef unsigned u32x4 __attribute__((ext_vector_type(4)));
typedef unsigned u32x2 __attribute__((ext_vector_type(2)));

constexpr int T_TOK = 16384, DM = 1024, SEQ = 2048, INW = 12296;
constexpr int LDS_BAR_OFF = 150784;
constexpr int LDS_BYTES = 150800;
#ifndef REP0
#define REP0 1
#endif
#ifndef REP1
#define REP1 1
#endif
#ifndef REP2
#define REP2 1
#endif
#ifndef REP8
#define REP8 1
#endif
#ifndef REPA
#define REPA 1
#endif
#ifndef REPB
#define REPB 1
#endif
#ifndef REP4
#define REP4 1
#endif
#ifndef MLX2
#define MLX2 1
#endif
#ifndef REPC
#define REPC 1
#endif
#ifndef REP7
#define REP7 1
#endif
constexpr float EPS = 1e-6f;
constexpr size_t WS_WIN = 0;
constexpr size_t WS_WPM = 25165824;
constexpr size_t WS_WPA = WS_WPM + 2097152;
constexpr size_t WS_WOUT = WS_WPA + 1048576;
constexpr size_t WS_GATES = WS_WOUT + 2097152;
constexpr size_t WS_R1 = WS_GATES + 524288;
constexpr size_t WS_R2 = WS_R1 + 167772160;
constexpr size_t WS_SSQ = WS_R2 + 67108864;
constexpr size_t WS_ROPE = WS_SSQ + 2097152;
constexpr size_t WS_BAR = WS_ROPE + 262144;
constexpr size_t WS_END = WS_BAR + 16384;
constexpr size_t OUT_H = 0, OUT_HM = 33554432, OUT_ML = 0, OUT_ATT = 4194304;
constexpr size_t R1_KA = 67108864, R1_VA = R1_KA + 50331648;
constexpr int QZ_LD = 2048;
constexpr size_t R1_TMP = 0, R1_MG = 67108864, R1_Y = 100663296;

struct Params {
    const float* x; const float* pre_w; const float* w_in; const float* b_if; const float* conv_w; const float* conv_b;
    const float* m_norm_w; const float* w_pm; const float* w_pa; const float* w_out; const float* post_w;
    float* out; unsigned char* ws; int ph_lo, ph_hi;
};

__device__ __forceinline__ float bf2f(unsigned b) { return __uint_as_float(b << 16); }
__device__ __forceinline__ float bflo(unsigned w) { return __uint_as_float(w << 16); }
__device__ __forceinline__ float bfhi(unsigned w) { return __uint_as_float(w & 0xffff0000u); }
typedef __bf16 bf16x2_t __attribute__((ext_vector_type(2)));
typedef float f32x2_t __attribute__((ext_vector_type(2)));
__device__ __forceinline__ unsigned cvt_pk_bf16(float lo, float hi) { const f32x2_t f = {lo, hi}; const bf16x2_t b = __builtin_convertvector(f, bf16x2_t); return __builtin_bit_cast(unsigned, b); }
__device__ __forceinline__ bf16_t f2bf(float f) { return (bf16_t)(cvt_pk_bf16(f, 0.f) & 0xffffu); }
__device__ __forceinline__ float sigmoidf_(float x) { return __builtin_amdgcn_rcpf(1.0f + __expf(-x)); }
__device__ __forceinline__ float siluf_(float x) { return x * sigmoidf_(x); }
__device__ __forceinline__ void unpack8(const u32x4 w, float (&f)[8]) {
    f[0] = bflo(w.x); f[1] = bfhi(w.x); f[2] = bflo(w.y); f[3] = bfhi(w.y); f[4] = bflo(w.z); f[5] = bfhi(w.z); f[6] = bflo(w.w); f[7] = bfhi(w.w);
}
__device__ __forceinline__ u32x4 pack8(const float (&f)[8]) {
    u32x4 w; w.x = cvt_pk_bf16(f[0], f[1]); w.y = cvt_pk_bf16(f[2], f[3]); w.z = cvt_pk_bf16(f[4], f[5]); w.w = cvt_pk_bf16(f[6], f[7]); return w;
}
__device__ __forceinline__ void st_wt16(void* p, u32x4 v) { asm volatile("global_store_dwordx4 %0, %1, off sc1\n\ts_nop 1" : : "v"(p), "v"(v) : "memory"); }
__device__ __forceinline__ void st_wt16_o256(void* p, u32x4 v) { asm volatile("global_store_dwordx4 %0, %1, off offset:256 sc1\n\ts_nop 1" : : "v"(p), "v"(v) : "memory"); }
typedef short s16x4 __attribute__((ext_vector_type(4)));
__device__ __forceinline__ u32x2 tr_read(LAS unsigned char* addr) { const s16x4 v = __builtin_amdgcn_ds_read_tr16_b64_v4i16((LAS s16x4*)addr); return __builtin_bit_cast(u32x2, v); }
__device__ __forceinline__ u32x4 ldg16(const void* base, unsigned off) { return *(const u32x4*)((const char*)base + off); }
__device__ __forceinline__ u32x2 ldg8(const void* base, unsigned off) { return *(const u32x2*)((const char*)base + off); }
__device__ __forceinline__ void stg8(void* base, unsigned off, u32x2 v) { *(u32x2*)((char*)base + off) = v; }
__device__ __forceinline__ float wave_sum(float v) {
    v += __shfl_xor(v, 32); v += __shfl_xor(v, 16); v += __shfl_xor(v, 8); v += __shfl_xor(v, 4); v += __shfl_xor(v, 2); v += __shfl_xor(v, 1); return v;
}

#define XB_TMO      128
#define XB_XCNT(j)  (256  + 64 * (j))
#define XB_XSUB(j)  (1280 + 64 * (j))
#define XB_XGEN(j)  (2304 + 64 * (j))
#define XB_TOP      3328
#define XB_TOPGEN   3392
#define XCD_BAR_WORDS 3456
#define XB_SPIN_CAP (1u << 18)
__device__ __forceinline__ unsigned xb_ld(unsigned* p)              { return __hip_atomic_load(p, __ATOMIC_RELAXED, __HIP_MEMORY_SCOPE_AGENT); }
__device__ __forceinline__ unsigned xb_add(unsigned* p, unsigned v) { return __hip_atomic_fetch_add(p, v, __ATOMIC_RELAXED, __HIP_MEMORY_SCOPE_AGENT); }
__device__ __forceinline__ unsigned xb_xcc_id() { return (unsigned)__builtin_amdgcn_s_getreg((3 << 11) | 20) & 0xFu; }
#define XB_SPIN(cond, bar) do { unsigned _sp = 0; while (cond) { __builtin_amdgcn_s_sleep(1); \
    if ((++_sp & 255u) == 0u) { if (xb_ld(&(bar)[XB_TMO])) break; if (_sp > XB_SPIN_CAP) { atomicAdd(&(bar)[XB_TMO], 1u); break; } } } } while (0)
struct XcdBarrier { unsigned* bar; unsigned x; volatile LAS unsigned* st; };
__device__ __forceinline__ XcdBarrier xcd_barrier_post(unsigned* bar, volatile LAS unsigned* st) {
    XcdBarrier b; b.bar = bar; b.x = xb_xcc_id(); b.st = st;
    if (threadIdx.x == 0) (void)xb_add(&bar[XB_XCNT(b.x)], 1u);
    return b;
}
__device__ __forceinline__ void xcd_barrier_complete(unsigned* bar, unsigned x, unsigned& nloc, unsigned& nx) {
    const unsigned G = gridDim.x * gridDim.y * gridDim.z;
    unsigned sum, cnt, mine, sp = 0u;
    for (;;) {
        sum = 0u; cnt = 0u; mine = 0u;
#pragma unroll
        for (unsigned j = 0; j < 16; ++j) { const unsigned c = xb_ld(&bar[XB_XCNT(j)]); sum += c; cnt += (c > 0u) ? 1u : 0u; mine = (j == x) ? c : mine; }
        if (sum == G) break;
        __builtin_amdgcn_s_sleep(1);
        if ((++sp & 255u) == 0u) { if (xb_ld(&bar[XB_TMO])) break; if (sp > XB_SPIN_CAP) { atomicAdd(&bar[XB_TMO], 1u); break; } }
    }
    nloc = mine > 0u ? mine : 1u; nx = cnt > 0u ? cnt : 1u;
}
__device__ __forceinline__ void xcd_barrier(const XcdBarrier& b) {
    asm volatile("s_waitcnt vmcnt(0)" ::: "memory");
    __syncthreads();
    if (threadIdx.x == 0) {
        unsigned* bar = b.bar;
        __builtin_amdgcn_s_waitcnt(0);
        unsigned nloc = b.st[0], nx = b.st[1];
        if (nloc == 0u) { xcd_barrier_complete(bar, b.x, nloc, nx); b.st[0] = nloc; b.st[1] = nx; }
        const unsigned old = xb_add(&bar[XB_XSUB(b.x)], 1u);
        const unsigned gen = old / nloc;
        if (old + 1u == (gen + 1u) * nloc) {
            __builtin_amdgcn_fence(__ATOMIC_RELEASE, "agent");
            asm volatile("s_waitcnt vmcnt(0)" ::: "memory");
            const unsigned og = xb_add(&bar[XB_TOP], 1u);
            const unsigned tg = og / nx;
            if (og + 1u == (tg + 1u) * nx) xb_add(&bar[XB_TOPGEN], 1u);
            else XB_SPIN(xb_ld(&bar[XB_TOPGEN]) == tg, bar);
            __builtin_amdgcn_fence(__ATOMIC_ACQUIRE, "agent");
            xb_add(&bar[XB_XGEN(b.x)], 1u);
            asm volatile("s_waitcnt vmcnt(0)" ::: "memory");
        } else {
            XB_SPIN(xb_ld(&bar[XB_XGEN(b.x)]) == gen, bar);
            __builtin_amdgcn_fence(__ATOMIC_ACQUIRE, "agent");
            asm volatile("s_waitcnt vmcnt(0)" ::: "memory");
        }
    }
    __syncthreads();
}

namespace pg8 {
constexpr int BM = 256, BK = 64, HALF = 128, HTB = HALF * BK * 2, STAGE_BYTES = 8 * HTB, NXCD = 8, WGM = 4;
__device__ __forceinline__ int lds_byte(int r, int c) { const int st = (r >> 4) * 2 + (c >> 5), rr = r & 15, cc = c & 31, ob = rr * 64 + cc * 2; return st * 1024 + (ob ^ (((ob >> 9) & 1) << 5)); }
__device__ __forceinline__ void stage_rc(int b, int& R, int& C) { const int st = b / 1024, sb = b % 1024, swz = sb ^ (((sb >> 9) & 1) << 5); R = (st >> 1) * 16 + swz / 64; C = (st & 1) * 32 + (swz % 64) / 2; }
__device__ __forceinline__ int perm32(int rho) { const int n = rho >> 4, i = rho & 15; return 8 * (i >> 2) + 4 * n + (i & 3); }
struct Unit { int pm, pn; };
struct Gemm { const bf16_t* A; const bf16_t* Bt; int M, N, K; };
struct StaticOrder {
    int nM, nN, nwg, G, c;
    __device__ void init(int M, int N, int G_, int c_) { nM = M / BM; nN = N / BM; nwg = nM * nN; G = G_; c = c_; }
    __device__ bool next(int i, Unit& u) const {
        const long L = (long)i * G + c; if (L >= nwg) return false;
        int wgid = (int)L; { const int q = nwg / NXCD, r = nwg % NXCD, xcd = wgid % NXCD, off = wgid / NXCD; wgid = (xcd < r ? xcd * (q + 1) : r * (q + 1) + (xcd - r) * q) + off; }
        const int nig = WGM * nN, gid = wgid / nig, fm = gid * WGM, gsz = (nM - fm) < WGM ? (nM - fm) : WGM;
        u.pm = fm + ((wgid % nig) % gsz); u.pn = (wgid % nig) / gsz; return true;
    }
};

template <class Epi, bool AFTER = false>
__device__ __forceinline__ void gemm_phase(LAS unsigned char* lds, const Gemm g, const StaticOrder& S, const Epi& E) {
    const int tid = threadIdx.x, wid = __builtin_amdgcn_readfirstlane(tid >> 6), lane = tid & 63, wr = wid >> 2, wc = wid & 3, fr = lane & 15, fq = lane >> 4;
    const int K = g.K, nt = K / BK;
    unsigned voffA[2], voffB[2];
#pragma unroll
    for (int i = 0; i < 2; ++i) { int R, C; stage_rc(tid * 16 + i * 8192, R, C); const int Rb = (R & ~31) + perm32(R & 31);
        voffA[i] = (unsigned)(R * K + C) * 2u; voffB[i] = (unsigned)(Rb * K + C) * 2u; }
    const size_t kstep = (size_t)(BK * 2);
    const size_t hstep = (size_t)HALF * K * 2;
    const size_t tstep = 2 * hstep;
    const unsigned ldsw = (unsigned)wid * 1024u;
    const int aoff = lds_byte(wr * 64 + fr, fq * 8), boff = lds_byte(wc * 32 + fr, fq * 8);
#define PG8_SA(b, h) (((b) * 2 + (h)) * HTB)
#define PG8_SB(b, h) ((4 + (b) * 2 + (h)) * HTB)
#define PG8_STAGE(bufoff, gbase, voff) do { _Pragma("unroll") for (int _i = 0; _i < 2; ++_i) \
        __builtin_amdgcn_global_load_lds((const unsigned*)((const char*)(gbase) + (voff)[_i]), (LAS unsigned*)(lds + (bufoff) + ldsw + _i * 8192), 16, 0, 0); } while (0)
#define PG8_LDA(dst, b, h) do { _Pragma("unroll") for (int m = 0; m < 4; ++m) _Pragma("unroll") for (int k = 0; k < 2; ++k) dst[m][k] = *(const LAS bf16x8*)(lds + PG8_SA(b, h) + aoff + m * 2048 + k * 1024); } while (0)
#define PG8_LDB(dst, b, h) do { _Pragma("unroll") for (int n = 0; n < 2; ++n) _Pragma("unroll") for (int k = 0; k < 2; ++k) dst[n][k] = *(const LAS bf16x8*)(lds + PG8_SB(b, h) + boff + n * 2048 + k * 1024); } while (0)
#define PG8_MMA(ai, bj, At, Bt) do { __builtin_amdgcn_s_setprio(1); _Pragma("unroll") for (int m = 0; m < 4; ++m) _Pragma("unroll") for (int n = 0; n < 2; ++n) _Pragma("unroll") for (int k = 0; k < 2; ++k) \
        acc[ai][bj][m][n] = __builtin_amdgcn_mfma_f32_16x16x32_bf16(Bt[n][k], At[m][k], acc[ai][bj][m][n], 0, 0, 0); __builtin_amdgcn_s_setprio(0); } while (0)
#define PG8_WAIT_V(n) asm volatile("s_waitcnt vmcnt(" #n ")" ::: "memory")
#define PG8_WAIT_L(n) asm volatile("s_waitcnt lgkmcnt(" #n ")" ::: "memory")
#define PG8_BAR __builtin_amdgcn_s_barrier()
#define PG8_SCHED __builtin_amdgcn_sched_barrier(0)
    Unit cur, nxt; int ui = 0;
    if (!S.next(0, cur)) return;
    f32x4 acc[2][2][4][2];
#pragma unroll
    for (int a = 0; a < 2; ++a)
#pragma unroll
        for (int b = 0; b < 2; ++b)
#pragma unroll
            for (int m = 0; m < 4; ++m)
#pragma unroll
                for (int n = 0; n < 2; ++n) acc[a][b][m][n] = (f32x4){0.f, 0.f, 0.f, 0.f};
    bf16x8 At[4][2], B0[2][2], B1[2][2];
    const char* cA = (const char*)g.A + (size_t)cur.pm * tstep; const char* cB = (const char*)g.Bt + (size_t)cur.pn * tstep;
    PG8_STAGE(PG8_SB(0, 0), cB, voffB); PG8_STAGE(PG8_SA(0, 0), cA, voffA); PG8_STAGE(PG8_SB(0, 1), cB + hstep, voffB); PG8_STAGE(PG8_SA(0, 1), cA + hstep, voffA);
    if (wr == 1) PG8_BAR;
    PG8_WAIT_V(4); PG8_BAR;
    PG8_STAGE(PG8_SB(1, 0), cB + kstep, voffB); PG8_STAGE(PG8_SA(1, 0), cA + kstep, voffA); PG8_STAGE(PG8_SB(1, 1), cB + hstep + kstep, voffB);
    PG8_WAIT_V(6); PG8_BAR;
    for (;;) {
        const bool has_next = S.next(ui + 1, nxt);
        const char* nA = has_next ? (const char*)g.A + (size_t)nxt.pm * tstep : cA; const char* nB = has_next ? (const char*)g.Bt + (size_t)nxt.pn * tstep : cB;
        for (int t = 0; t < nt; t += 2) {
            const bool last = (t == nt - 2);
            const char* a1 = cA + (size_t)(t + 1) * kstep;
            const char* a2 = last ? nA : cA + (size_t)(t + 2) * kstep; const char* b2 = last ? nB : cB + (size_t)(t + 2) * kstep;
            const char* a3 = a2 + kstep; const char* b3 = b2 + kstep;
            PG8_LDB(B0, 0, 0); PG8_SCHED; PG8_LDA(At, 0, 0); PG8_STAGE(PG8_SA(1, 1), a1 + hstep, voffA);
            PG8_WAIT_L(8); PG8_BAR; PG8_WAIT_L(0); PG8_MMA(0, 0, At, B0); PG8_BAR; PG8_SCHED;
            PG8_LDB(B1, 0, 1); PG8_STAGE(PG8_SB(0, 0), b2, voffB);
            PG8_BAR; PG8_WAIT_L(0); PG8_MMA(0, 1, At, B1); PG8_BAR;
            PG8_LDA(At, 0, 1); PG8_STAGE(PG8_SA(0, 0), a2, voffA);
            PG8_BAR; PG8_WAIT_L(0); PG8_MMA(1, 0, At, B0); PG8_BAR; PG8_SCHED;
            PG8_STAGE(PG8_SB(0, 1), b2 + hstep, voffB);
            PG8_WAIT_V(6); PG8_BAR; PG8_MMA(1, 1, At, B1); PG8_BAR;
            PG8_LDB(B0, 1, 0); PG8_SCHED; PG8_LDA(At, 1, 0); PG8_STAGE(PG8_SA(0, 1), a2 + hstep, voffA);
            PG8_WAIT_L(8); PG8_BAR; PG8_WAIT_L(0); PG8_MMA(0, 0, At, B0); PG8_BAR; PG8_SCHED;
            PG8_LDB(B1, 1, 1); PG8_STAGE(PG8_SB(1, 0), b3, voffB);
            PG8_BAR; PG8_WAIT_L(0); PG8_MMA(0, 1, At, B1); PG8_BAR;
            PG8_LDA(At, 1, 1); PG8_STAGE(PG8_SA(1, 0), a3, voffA);
            PG8_BAR; PG8_WAIT_L(0); PG8_MMA(1, 0, At, B0); PG8_BAR; PG8_SCHED;
            PG8_STAGE(PG8_SB(1, 1), b3 + hstep, voffB);
            PG8_WAIT_V(6); PG8_BAR; PG8_MMA(1, 1, At, B1); PG8_BAR;
        }
        if constexpr (!AFTER) E(acc, cur, wr, wc, fr, fq);
        if (!has_next) break;
#pragma unroll
        for (int a = 0; a < 2; ++a)
#pragma unroll
            for (int b = 0; b < 2; ++b)
#pragma unroll
                for (int m = 0; m < 4; ++m)
#pragma unroll
                    for (int n = 0; n < 2; ++n) acc[a][b][m][n] = (f32x4){0.f, 0.f, 0.f, 0.f};
        cur = nxt; cA = nA; cB = nB; ++ui;
    }
    PG8_WAIT_V(0);
    if (wr == 0) PG8_BAR;
    PG8_BAR;
    if constexpr (AFTER) E.fused(acc, cur, wr, wc, fr, fq, lds, wid, lane);
#undef PG8_SA
#undef PG8_SB
#undef PG8_STAGE
#undef PG8_LDA
#undef PG8_LDB
#undef PG8_MMA
#undef PG8_WAIT_V
#undef PG8_WAIT_L
#undef PG8_BAR
#undef PG8_SCHED
}
template <class EpiMid, class EpiEnd>
__device__ __forceinline__ void gemm_phase2(LAS unsigned char* lds, const Gemm g0, const Gemm g1, const StaticOrder& S, const EpiMid& Emid, const EpiEnd& Eend) {
    const int tid = threadIdx.x, wid = __builtin_amdgcn_readfirstlane(tid >> 6), lane = tid & 63, wr = wid >> 2, wc = wid & 3, fr = lane & 15, fq = lane >> 4;
    unsigned rA2[2], rB2[2], cb2[2];
#pragma unroll
    for (int i = 0; i < 2; ++i) { int R, C; stage_rc(tid * 16 + i * 8192, R, C); const int Rb = (R & ~31) + perm32(R & 31); rA2[i] = (unsigned)R * 2u; rB2[i] = (unsigned)Rb * 2u; cb2[i] = (unsigned)C * 2u; }
    const size_t kstep = (size_t)(BK * 2);
    const unsigned K0 = (unsigned)g0.K, K1 = (unsigned)g1.K;
    const size_t hstep0 = (size_t)HALF * g0.K * 2, hstep1 = (size_t)HALF * g1.K * 2;
    const unsigned ldsw = (unsigned)wid * 1024u;
    const int aoff = lds_byte(wr * 64 + fr, fq * 8), boff = lds_byte(wc * 32 + fr, fq * 8);
#define PG8_SA(b, h) (((b) * 2 + (h)) * HTB)
#define PG8_SB(b, h) ((4 + (b) * 2 + (h)) * HTB)
#define PG8_STAGE2(bufoff, gbase, r2, Ksel) do { \
        __builtin_amdgcn_global_load_lds((const unsigned*)((const char*)(gbase) + ((r2)[0] * (Ksel) + cb2[0])), (LAS unsigned*)(lds + (bufoff) + ldsw), 16, 0, 0); \
        __builtin_amdgcn_global_load_lds((const unsigned*)((const char*)(gbase) + ((r2)[1] * (Ksel) + cb2[1])), (LAS unsigned*)(lds + (bufoff) + ldsw + 8192), 16, 0, 0); } while (0)
#define PG8_LDA(dst, b, h) do { _Pragma("unroll") for (int m = 0; m < 4; ++m) _Pragma("unroll") for (int k = 0; k < 2; ++k) dst[m][k] = *(const LAS bf16x8*)(lds + PG8_SA(b, h) + aoff + m * 2048 + k * 1024); } while (0)
#define PG8_LDB(dst, b, h) do { _Pragma("unroll") for (int n = 0; n < 2; ++n) _Pragma("unroll") for (int k = 0; k < 2; ++k) dst[n][k] = *(const LAS bf16x8*)(lds + PG8_SB(b, h) + boff + n * 2048 + k * 1024); } while (0)
#define PG8_MMA(ai, bj, At, Bt) do { __builtin_amdgcn_s_setprio(1); _Pragma("unroll") for (int m = 0; m < 4; ++m) _Pragma("unroll") for (int n = 0; n < 2; ++n) _Pragma("unroll") for (int k = 0; k < 2; ++k) \
        acc[ai][bj][m][n] = __builtin_amdgcn_mfma_f32_16x16x32_bf16(Bt[n][k], At[m][k], acc[ai][bj][m][n], 0, 0, 0); __builtin_amdgcn_s_setprio(0); } while (0)
#define PG8_WAIT_V(n) asm volatile("s_waitcnt vmcnt(" #n ")" ::: "memory")
#define PG8_WAIT_L(n) asm volatile("s_waitcnt lgkmcnt(" #n ")" ::: "memory")
#define PG8_BAR __builtin_amdgcn_s_barrier()
#define PG8_SCHED __builtin_amdgcn_sched_barrier(0)
    Unit cur, nxt; int ui = 0;
    if (!S.next(0, cur)) return;
    f32x4 acc[2][2][4][2];
#pragma unroll
    for (int a = 0; a < 2; ++a)
#pragma unroll
        for (int b = 0; b < 2; ++b)
#pragma unroll
            for (int m = 0; m < 4; ++m)
#pragma unroll
                for (int n = 0; n < 2; ++n) acc[a][b][m][n] = (f32x4){0.f, 0.f, 0.f, 0.f};
    bf16x8 At[4][2], B0[2][2], B1[2][2];
    const char* cA = (const char*)g0.A + (size_t)cur.pm * 2 * hstep0; const char* cB = (const char*)g0.Bt + (size_t)cur.pn * 2 * hstep0;
    PG8_STAGE2(PG8_SB(0, 0), cB, rB2, K0); PG8_STAGE2(PG8_SA(0, 0), cA, rA2, K0);
    PG8_STAGE2(PG8_SB(0, 1), cB + hstep0, rB2, K0); PG8_STAGE2(PG8_SA(0, 1), cA + hstep0, rA2, K0);
    if (wr == 1) PG8_BAR;
    PG8_WAIT_V(4); PG8_BAR;
    PG8_STAGE2(PG8_SB(1, 0), cB + kstep, rB2, K0); PG8_STAGE2(PG8_SA(1, 0), cA + kstep, rA2, K0); PG8_STAGE2(PG8_SB(1, 1), cB + hstep0 + kstep, rB2, K0);
    PG8_WAIT_V(6); PG8_BAR;
    for (;;) {
        const bool has_next = S.next(ui + 1, nxt);
#pragma unroll 1
        for (int seg = 0; seg < 2; ++seg) {
            const int nt = (seg == 0 ? g0.K : g1.K) / BK;
            const size_t hs = seg == 0 ? hstep0 : hstep1, hsn = seg == 0 ? hstep1 : hstep0;
            const unsigned Kc = seg == 0 ? K0 : K1, Kn = seg == 0 ? K1 : K0;
            const Unit& nu = (seg == 0) ? cur : (has_next ? nxt : cur);
            const char* nA = (seg == 0) ? (const char*)g1.A + (size_t)nu.pm * 2 * hstep1 : (const char*)g0.A + (size_t)nu.pm * 2 * hstep0;
            const char* nB = (seg == 0) ? (const char*)g1.Bt + (size_t)nu.pn * 2 * hstep1 : (const char*)g0.Bt + (size_t)nu.pn * 2 * hstep0;
            for (int t = 0; t < nt; t += 2) {
                const bool last = (t == nt - 2);
                const char* a1 = cA + (size_t)(t + 1) * kstep;
                const char* a2 = last ? nA : cA + (size_t)(t + 2) * kstep; const char* b2 = last ? nB : cB + (size_t)(t + 2) * kstep;
                const char* a3 = a2 + kstep; const char* b3 = b2 + kstep;
                const size_t h2 = last ? hsn : hs;
                const unsigned K2 = last ? Kn : Kc;
                PG8_LDB(B0, 0, 0); PG8_SCHED; PG8_LDA(At, 0, 0); PG8_STAGE2(PG8_SA(1, 1), a1 + hs, rA2, Kc);
                PG8_WAIT_L(8); PG8_BAR; PG8_WAIT_L(0); PG8_MMA(0, 0, At, B0); PG8_BAR; PG8_SCHED;
                PG8_LDB(B1, 0, 1); PG8_STAGE2(PG8_SB(0, 0), b2, rB2, K2);
                PG8_BAR; PG8_WAIT_L(0); PG8_MMA(0, 1, At, B1); PG8_BAR;
                PG8_LDA(At, 0, 1); PG8_STAGE2(PG8_SA(0, 0), a2, rA2, K2);
                PG8_BAR; PG8_WAIT_L(0); PG8_MMA(1, 0, At, B0); PG8_BAR; PG8_SCHED;
                PG8_STAGE2(PG8_SB(0, 1), b2 + h2, rB2, K2);
                PG8_WAIT_V(6); PG8_BAR; PG8_MMA(1, 1, At, B1); PG8_BAR;
                PG8_LDB(B0, 1, 0); PG8_SCHED; PG8_LDA(At, 1, 0); PG8_STAGE2(PG8_SA(0, 1), a2 + h2, rA2, K2);
                PG8_WAIT_L(8); PG8_BAR; PG8_WAIT_L(0); PG8_MMA(0, 0, At, B0); PG8_BAR; PG8_SCHED;
                PG8_LDB(B1, 1, 1); PG8_STAGE2(PG8_SB(1, 0), b3, rB2, K2);
                PG8_BAR; PG8_WAIT_L(0); PG8_MMA(0, 1, At, B1); PG8_BAR;
                PG8_LDA(At, 1, 1); PG8_STAGE2(PG8_SA(1, 0), a3, rA2, K2);
                PG8_BAR; PG8_WAIT_L(0); PG8_MMA(1, 0, At, B0); PG8_BAR; PG8_SCHED;
                PG8_STAGE2(PG8_SB(1, 1), b3 + h2, rB2, K2);
                PG8_WAIT_V(6); PG8_BAR; PG8_MMA(1, 1, At, B1); PG8_BAR;
            }
            if (seg == 0) Emid(acc, cur, wr, wc, fr, fq); else Eend(acc, cur, wr, wc, fr, fq);
            cA = nA; cB = nB;
        }
        if (!has_next) break;
#pragma unroll
        for (int a = 0; a < 2; ++a)
#pragma unroll
            for (int b = 0; b < 2; ++b)
#pragma unroll
                for (int m = 0; m < 4; ++m)
#pragma unroll
                    for (int n = 0; n < 2; ++n) acc[a][b][m][n] = (f32x4){0.f, 0.f, 0.f, 0.f};
        cur = nxt; ++ui;
    }
    PG8_WAIT_V(0);
    if (wr == 0) PG8_BAR;
    PG8_BAR;
#undef PG8_SA
#undef PG8_SB
#undef PG8_STAGE2
#undef PG8_LDA
#undef PG8_LDB
#undef PG8_MMA
#undef PG8_WAIT_V
#undef PG8_WAIT_L
#undef PG8_BAR
#undef PG8_SCHED
}
}

#define EPI_LOOP_BEGIN \
    const int row0 = u.pm * 256 + wr * 64 + fr; \
    _Pragma("unroll") for (int ai = 0; ai < 2; ++ai) _Pragma("unroll") for (int m = 0; m < 4; ++m) { const int row = row0 + ai * 128 + m * 16; \
    _Pragma("unroll") for (int bj = 0; bj < 2; ++bj) { const f32x4 v0 = acc[ai][bj][m][0], v1 = acc[ai][bj][m][1];
#define EPI_LOOP_END } }

struct EpiStoreBf16 {
    bf16_t* O1; int ld1; int split_pn; bf16_t* O2; int ld2;
    __device__ __forceinline__ void operator()(const f32x4 (&acc)[2][2][4][2], const pg8::Unit& u, int wr, int wc, int fr, int fq) const {
        bf16_t* base; int ld, colt;
        if (u.pn < split_pn) { base = O1; ld = ld1; colt = u.pn * 256; } else { base = O2; ld = ld2; colt = (u.pn - split_pn) * 256; }
        const int col0 = colt + wc * 32 + 8 * fq; const int row0 = u.pm * 256 + wr * 64 + fr;
#pragma unroll
        for (int ai = 0; ai < 2; ++ai)
#pragma unroll
            for (int m = 0; m < 4; ++m) {
                bf16_t* rp = base + (size_t)(row0 + ai * 128 + m * 16) * ld + col0;
                u32x4 w0, w1;
                w0.x = cvt_pk_bf16(acc[ai][0][m][0][0], acc[ai][0][m][0][1]); w0.y = cvt_pk_bf16(acc[ai][0][m][0][2], acc[ai][0][m][0][3]);
                w0.z = cvt_pk_bf16(acc[ai][0][m][1][0], acc[ai][0][m][1][1]); w0.w = cvt_pk_bf16(acc[ai][0][m][1][2], acc[ai][0][m][1][3]);
                w1.x = cvt_pk_bf16(acc[ai][1][m][0][0], acc[ai][1][m][0][1]); w1.y = cvt_pk_bf16(acc[ai][1][m][0][2], acc[ai][1][m][0][3]);
                w1.z = cvt_pk_bf16(acc[ai][1][m][1][0], acc[ai][1][m][1][1]); w1.w = cvt_pk_bf16(acc[ai][1][m][1][2], acc[ai][1][m][1][3]);
                st_wt16(rp, w0); st_wt16_o256(rp, w1);
            }
    }
};
struct EpiProjB {
    bf16_t* QZ; bf16_t* KA; bf16_t* VA; bf16_t* Gm;
    __device__ __forceinline__ void operator()(const f32x4 (&acc)[2][2][4][2], const pg8::Unit& u, int wr, int wc, int fr, int fq) const {
        const int pn = u.pn; const int row0 = u.pm * 256 + wr * 64 + fr; const int cl = wc * 32 + 8 * fq;
#pragma unroll
        for (int ai = 0; ai < 2; ++ai)
#pragma unroll
            for (int m = 0; m < 4; ++m) {
                const int row = row0 + ai * 128 + m * 16;
                u32x4 w0, w1;
                w0.x = cvt_pk_bf16(acc[ai][0][m][0][0], acc[ai][0][m][0][1]); w0.y = cvt_pk_bf16(acc[ai][0][m][0][2], acc[ai][0][m][0][3]);
                w0.z = cvt_pk_bf16(acc[ai][0][m][1][0], acc[ai][0][m][1][1]); w0.w = cvt_pk_bf16(acc[ai][0][m][1][2], acc[ai][0][m][1][3]);
                w1.x = cvt_pk_bf16(acc[ai][1][m][0][0], acc[ai][1][m][0][1]); w1.y = cvt_pk_bf16(acc[ai][1][m][0][2], acc[ai][1][m][0][3]);
                w1.z = cvt_pk_bf16(acc[ai][1][m][1][0], acc[ai][1][m][1][1]); w1.w = cvt_pk_bf16(acc[ai][1][m][1][2], acc[ai][1][m][1][3]);
                if (pn < 6) { bf16_t* rp = QZ + (size_t)row * QZ_LD + pn * 256 + cl; st_wt16(rp, w0); st_wt16_o256(rp, w1); }
                else if (pn < 18) {
                    bf16_t* base = (pn < 12) ? KA : VA; const int c = (pn < 12 ? pn - 6 : pn - 12) * 256 + cl;
                    const int b = row >> 11, pos = row & 2047;
#pragma unroll
                    for (int bj = 0; bj < 2; ++bj) {
                        const int cc = c + bj * 128; const int g = cc >> 9, h = (cc >> 7) & 3, e = cc & 127; const int lg = 2 * g;
                        const int rr = pos & ((1 << lg) - 1), j = pos >> lg;
                        const size_t off = (size_t)g * ((size_t)T_TOK * 512) + ((size_t)((((b * 4 + h) << lg) + rr) * (2048 >> lg) + j)) * 128 + e;
                        st_wt16(base + off, bj == 0 ? w0 : w1);
                    }
                }
                else if (pn < 20) { bf16_t* rp = QZ + (size_t)row * QZ_LD + 1536 + (pn - 18) * 256 + cl; st_wt16(rp, w0); st_wt16_o256(rp, w1); }
                else { bf16_t* rp = Gm + (size_t)row * 2048 + (pn - 20) * 256 + cl; st_wt16(rp, w0); st_wt16_o256(rp, w1); }
            }
    }
};
struct EpiGateF32 {
    const bf16_t* Gt; float* TMP;
    __device__ __forceinline__ void operator()(const f32x4 (&acc)[2][2][4][2], const pg8::Unit& u, int wr, int wc, int fr, int fq) const {
        const int col0 = u.pn * 256 + wc * 32 + 8 * fq; const int row0 = u.pm * 256 + wr * 64 + fr;
#pragma unroll
        for (int ai = 0; ai < 2; ++ai) {
            u32x4 gw[4][2];
#pragma unroll
            for (int m = 0; m < 4; ++m)
#pragma unroll
                for (int bj = 0; bj < 2; ++bj) gw[m][bj] = *(const u32x4*)(Gt + (size_t)(row0 + ai * 128 + m * 16) * 2048 + col0 + bj * 128);
#pragma unroll
            for (int m = 0; m < 4; ++m)
#pragma unroll
                for (int bj = 0; bj < 2; ++bj) {
                    const f32x4 v0 = acc[ai][bj][m][0], v1 = acc[ai][bj][m][1]; float gf[8]; unpack8(gw[m][bj], gf);
                    f32x4 o0, o1;
                    o0[0] = sigmoidf_(gf[0]) * v0[0]; o0[1] = sigmoidf_(gf[1]) * v0[1]; o0[2] = sigmoidf_(gf[2]) * v0[2]; o0[3] = sigmoidf_(gf[3]) * v0[3];
                    o1[0] = sigmoidf_(gf[4]) * v1[0]; o1[1] = sigmoidf_(gf[5]) * v1[1]; o1[2] = sigmoidf_(gf[6]) * v1[2]; o1[3] = sigmoidf_(gf[7]) * v1[3];
                    float* tp = TMP + (size_t)(row0 + ai * 128 + m * 16) * 1024 + col0 + bj * 128; *(f32x4*)tp = o0; *(f32x4*)(tp + 4) = o1;
                }
        }
    }
};
struct EpiMerge {
    const bf16_t* Gt; const float* TMP; bf16_t* MG;
    __device__ __forceinline__ void operator()(const f32x4 (&acc)[2][2][4][2], const pg8::Unit& u, int wr, int wc, int fr, int fq) const {
        const int col0 = u.pn * 256 + wc * 32 + 8 * fq; const int row0 = u.pm * 256 + wr * 64 + fr;
#pragma unroll
        for (int ai = 0; ai < 2; ++ai)
#pragma unroll
            for (int mp = 0; mp < 2; ++mp) {
                u32x4 gw[2][2]; f32x4 t0[2][2], t1[2][2];
#pragma unroll
                for (int mm = 0; mm < 2; ++mm)
#pragma unroll
                    for (int bj = 0; bj < 2; ++bj) {
                        const size_t row = (size_t)(row0 + ai * 128 + (2 * mp + mm) * 16); const int col = col0 + bj * 128;
                        gw[mm][bj] = *(const u32x4*)(Gt + row * 2048 + 1024 + col);
                        const float* tp = TMP + row * 1024 + col; t0[mm][bj] = *(const f32x4*)tp; t1[mm][bj] = *(const f32x4*)(tp + 4);
                    }
#pragma unroll
                for (int mm = 0; mm < 2; ++mm)
#pragma unroll
                    for (int bj = 0; bj < 2; ++bj) {
                        const int m = 2 * mp + mm; const f32x4 v0 = acc[ai][bj][m][0], v1 = acc[ai][bj][m][1]; float gf[8]; unpack8(gw[mm][bj], gf);
                        float o[8];
                        o[0] = t0[mm][bj][0] + sigmoidf_(gf[0]) * v0[0]; o[1] = t0[mm][bj][1] + sigmoidf_(gf[1]) * v0[1]; o[2] = t0[mm][bj][2] + sigmoidf_(gf[2]) * v0[2]; o[3] = t0[mm][bj][3] + sigmoidf_(gf[3]) * v0[3];
                        o[4] = t1[mm][bj][0] + sigmoidf_(gf[4]) * v1[0]; o[5] = t1[mm][bj][1] + sigmoidf_(gf[5]) * v1[1]; o[6] = t1[mm][bj][2] + sigmoidf_(gf[6]) * v1[2]; o[7] = t1[mm][bj][3] + sigmoidf_(gf[7]) * v1[3];
                        *(u32x4*)(MG + (size_t)(row0 + ai * 128 + m * 16) * 1024 + col0 + bj * 128) = pack8(o);
                    }
            }
    }
};
struct EpiRatio {
    const bf16_t* Gt;
    __device__ __forceinline__ void operator()(f32x4 (&acc)[2][2][4][2], const pg8::Unit& u, int wr, int wc, int fr, int fq) const {
        unsigned goff = ((unsigned)(u.pm * 256 + wr * 64 + fr) * 2048u + (unsigned)(u.pn * 256 + wc * 32 + 8 * fq)) * 2u;
        asm volatile("" : "+v"(goff));
#pragma unroll
        for (int ai = 0; ai < 2; ++ai)
#pragma unroll
            for (int mp = 0; mp < 2; ++mp) {
                u32x4 gm[2][2], ga[2][2];
#pragma unroll
                for (int mm = 0; mm < 2; ++mm) {
                    const unsigned ro = goff + (unsigned)(ai * 128 + (2 * mp + mm) * 16) * 4096u;
#pragma unroll
                    for (int bj = 0; bj < 2; ++bj) { gm[mm][bj] = *(const u32x4*)((const char*)Gt + (ro + 256u * bj)); ga[mm][bj] = *(const u32x4*)((const char*)Gt + (ro + 2048u + 256u * bj)); }
                }
#pragma unroll
                for (int mm = 0; mm < 2; ++mm)
#pragma unroll
                    for (int bj = 0; bj < 2; ++bj) {
                        const int m = 2 * mp + mm; float fm[8], fa[8]; unpack8(gm[mm][bj], fm); unpack8(ga[mm][bj], fa);
#pragma unroll
                        for (int e = 0; e < 8; ++e) {
                            const float ratio = (1.0f + __expf(-fa[e])) * __builtin_amdgcn_rcpf(1.0f + __expf(-fm[e]));
                            acc[ai][bj][m][e >> 2][e & 3] *= ratio;
                        }
                    }
                asm volatile("" ::: "memory");
            }
    }
};
struct EpiMerge2 {
    const bf16_t* Gt; bf16_t* MG;
    __device__ __forceinline__ void operator()(f32x4 (&acc)[2][2][4][2], const pg8::Unit& u, int wr, int wc, int fr, int fq) const {
        const unsigned row0 = (unsigned)(u.pm * 256 + wr * 64 + fr), col0 = (unsigned)(u.pn * 256 + wc * 32 + 8 * fq);
        unsigned goff = (row0 * 2048u + 1024u + col0) * 2u, moff = (row0 * 1024u + col0) * 2u;
        asm volatile("" : "+v"(goff), "+v"(moff));
#pragma unroll
        for (int ai = 0; ai < 2; ++ai) {
            u32x4 ga[4][2];
#pragma unroll
            for (int m = 0; m < 4; ++m)
#pragma unroll
                for (int bj = 0; bj < 2; ++bj) ga[m][bj] = *(const u32x4*)((const char*)Gt + (goff + (unsigned)(ai * 128 + m * 16) * 4096u + 256u * bj));
#pragma unroll
            for (int m = 0; m < 4; ++m) {
                const unsigned rm = moff + (unsigned)(ai * 128 + m * 16) * 2048u;
#pragma unroll
                for (int bj = 0; bj < 2; ++bj) {
                    float fa[8], o[8]; unpack8(ga[m][bj], fa);
#pragma unroll
                    for (int e = 0; e < 8; ++e) o[e] = sigmoidf_(fa[e]) * acc[ai][bj][m][e >> 2][e & 3];
                    *(u32x4*)((char*)MG + (rm + 256u * bj)) = pack8(o);
                }
            }
            asm volatile("" ::: "memory");
        }
    }
};
struct EpiF32 {
    float* Y;
    __device__ __forceinline__ void operator()(const f32x4 (&acc)[2][2][4][2], const pg8::Unit& u, int wr, int wc, int fr, int fq) const {
        const int col0 = u.pn * 256 + wc * 32 + 8 * fq;
        EPI_LOOP_BEGIN
            float* yp = Y + (size_t)row * 1024 + col0 + bj * 128; *(f32x4*)yp = v0; *(f32x4*)(yp + 4) = v1;
        EPI_LOOP_END
    }
};

struct EpiRmsRes {
    const float* x; const float* post_w; float* out; float* X; unsigned* cnt;
    __device__ __forceinline__ void fused(f32x4 (&acc)[2][2][4][2], const pg8::Unit& u, int wr, int wc, int fr, int fq, LAS unsigned char* lds, int wid, int lane) const {
        LAS float* P = (LAS float*)lds;
        LAS float* S = (LAS float*)(lds + 4096);
        const int tid = threadIdx.x;
        const int col0 = u.pn * 256 + wc * 32 + 8 * fq;
        const size_t off0 = (size_t)(u.pm * 256 + wr * 64 + fr) * 1024 + col0;
        f32x4 xv[4][2][2];
#pragma unroll
        for (int m = 0; m < 4; ++m)
#pragma unroll
            for (int bj = 0; bj < 2; ++bj) { xv[m][bj][0] = *(const f32x4*)(x + off0 + (size_t)(m * 16) * 1024 + bj * 128); xv[m][bj][1] = *(const f32x4*)(x + off0 + (size_t)(m * 16) * 1024 + bj * 128 + 4); }
#pragma unroll
        for (int ai = 0; ai < 2; ++ai)
#pragma unroll
            for (int m = 0; m < 4; ++m) {
                float sq = 0.f;
#pragma unroll
                for (int bj = 0; bj < 2; ++bj)
#pragma unroll
                    for (int n = 0; n < 2; ++n) { const f32x4 v = acc[ai][bj][m][n]; sq += (v[0] * v[0] + v[1] * v[1]) + (v[2] * v[2] + v[3] * v[3]); }
                sq += __shfl_xor(sq, 16); sq += __shfl_xor(sq, 32);
                if (fq == 0) P[(ai * 128 + wr * 64 + m * 16 + fr) * 4 + wc] = sq;
            }
        __syncthreads();
        if (tid < 256) {
            const f32x4 pv = *(const LAS f32x4*)(P + tid * 4);
            __hip_atomic_store(X + ((size_t)u.pm * 256 + tid) * 4 + u.pn, (pv[0] + pv[1]) + (pv[2] + pv[3]), __ATOMIC_RELAXED, __HIP_MEMORY_SCOPE_AGENT);
        }
        asm volatile("s_waitcnt vmcnt(0)" ::: "memory");
        __syncthreads();
        if (tid == 0) {
            __hip_atomic_fetch_add(cnt + u.pm, 1u, __ATOMIC_RELAXED, __HIP_MEMORY_SCOPE_AGENT);
            for (unsigned sp = 0; sp < (1u << 22); ++sp) { if (__hip_atomic_load(cnt + u.pm, __ATOMIC_RELAXED, __HIP_MEMORY_SCOPE_AGENT) >= 4u) break; __builtin_amdgcn_s_sleep(1); }
            __builtin_amdgcn_fence(__ATOMIC_ACQUIRE, "agent");
            asm volatile("s_waitcnt vmcnt(0)" ::: "memory");
        }
        __syncthreads();
        if (tid < 256) {
            const float* xp = X + ((size_t)u.pm * 256 + tid) * 4;
            const float t = (__hip_atomic_load(xp, __ATOMIC_RELAXED, __HIP_MEMORY_SCOPE_AGENT) + __hip_atomic_load(xp + 1, __ATOMIC_RELAXED, __HIP_MEMORY_SCOPE_AGENT))
                          + (__hip_atomic_load(xp + 2, __ATOMIC_RELAXED, __HIP_MEMORY_SCOPE_AGENT) + __hip_atomic_load(xp + 3, __ATOMIC_RELAXED, __HIP_MEMORY_SCOPE_AGENT));
            S[tid] = rsqrtf(t * (1.0f / 1024.0f) + EPS);
        }
        __syncthreads();
        f32x4 pw[2][2];
#pragma unroll
        for (int bj = 0; bj < 2; ++bj) { pw[bj][0] = *(const f32x4*)(post_w + col0 + bj * 128); pw[bj][1] = *(const f32x4*)(post_w + col0 + bj * 128 + 4); }
#pragma unroll
        for (int ai = 0; ai < 2; ++ai) {
            if (ai == 1) {
#pragma unroll
                for (int m = 0; m < 4; ++m)
#pragma unroll
                    for (int bj = 0; bj < 2; ++bj) { xv[m][bj][0] = *(const f32x4*)(x + off0 + (size_t)(128 + m * 16) * 1024 + bj * 128); xv[m][bj][1] = *(const f32x4*)(x + off0 + (size_t)(128 + m * 16) * 1024 + bj * 128 + 4); }
            }
#pragma unroll
            for (int m = 0; m < 4; ++m) {
                const int lr = ai * 128 + wr * 64 + m * 16 + fr; const float rs = S[lr];
                const size_t off = off0 + (size_t)(ai * 128 + m * 16) * 1024;
#pragma unroll
                for (int bj = 0; bj < 2; ++bj) {
                    *(f32x4*)(out + off + bj * 128) = xv[m][bj][0] + acc[ai][bj][m][0] * rs * pw[bj][0];
                    *(f32x4*)(out + off + bj * 128 + 4) = xv[m][bj][1] + acc[ai][bj][m][1] * rs * pw[bj][1];
                }
            }
            asm volatile("" ::: "memory");
        }
    }
};

__device__ __forceinline__ void p0_prep(const Params& p, LAS unsigned char* lds) {
    const int tid = threadIdx.x, G = gridDim.x, bid = blockIdx.x, lane = tid & 63, wid = tid >> 6;
    unsigned char* ws = p.ws;
    LAS float* tile = (LAS float*)lds;
    LAS float* WG = (LAS float*)(lds + 32768);
    for (int i = tid; i < 2048; i += 512) { const int k = i >> 1, hf = i & 1; *(LAS f32x4*)(WG + k * 8 + hf * 4) = *(const f32x4*)(p.w_in + (size_t)k * INW + 5120 + hf * 4); }
    LAS float* strip = (LAS float*)(lds + 65536);
    for (int tI = bid; tI < 928; tI += G) {
        const float* src; bf16_t* dst; int ldn, Kdim, ns, kt, srccol;
        int u = tI;
        if (u < 768) { ns = u >> 4; kt = u & 15; src = p.w_in; ldn = INW; Kdim = 1024; dst = (bf16_t*)(ws + WS_WIN); srccol = ns * 256 + (ns >= 20 ? 8 : 0); }
        else if (u < 832) { u -= 768; ns = u >> 4; kt = u & 15; src = p.w_pm; ldn = 1024; Kdim = 1024; dst = (bf16_t*)(ws + WS_WPM); srccol = ns * 256; }
        else if (u < 864) { u -= 832; ns = u >> 3; kt = u & 7; src = p.w_pa; ldn = 1024; Kdim = 512; dst = (bf16_t*)(ws + WS_WPA); srccol = ns * 256; }
        else { u -= 864; ns = u >> 4; kt = u & 15; src = p.w_out; ldn = 1024; Kdim = 1024; dst = (bf16_t*)(ws + WS_WOUT); srccol = ns * 256; }
        float4 v[8];
#pragma unroll
        for (int i = 0; i < 8; ++i) { const int idx = tid + 512 * i; const int k = idx >> 6, n4 = idx & 63; v[i] = *(const float4*)(src + (size_t)(kt * 64 + k) * ldn + srccol + 4 * n4); }
#pragma unroll
        for (int i = 0; i < 8; ++i) { const int idx = tid + 512 * i; const int k = idx >> 6, n4 = idx & 63;
            strip[k * 257 + 4 * n4 + 0] = v[i].x; strip[k * 257 + 4 * n4 + 1] = v[i].y; strip[k * 257 + 4 * n4 + 2] = v[i].z; strip[k * 257 + 4 * n4 + 3] = v[i].w; }
        __syncthreads();
#pragma unroll
        for (int j = 0; j < 4; ++j) { const int piece = tid + 512 * j; const int n = piece >> 3, kv = piece & 7; float f[8];
#pragma unroll
            for (int e = 0; e < 8; ++e) f[e] = strip[(kv * 8 + e) * 257 + n];
            *(u32x4*)(dst + (size_t)(ns * 256 + n) * Kdim + kt * 64 + kv * 8) = pack8(f); }
        __syncthreads();
    }
    __syncthreads();
    bf16_t* H = (bf16_t*)((unsigned char*)p.out + OUT_H);
    float* GATES = (float*)(ws + WS_GATES);
    const float bias_l = p.b_if[((lane >> 5) & 1) * 4 + ((lane >> 4) & 1) * 2 + ((lane >> 3) & 1)];
    for (int row0 = (bid * 8 + wid) * 2; row0 < T_TOK; row0 += G * 16) {
        float4 v[2][4];
#pragma unroll
        for (int rr = 0; rr < 2; ++rr)
#pragma unroll
            for (int i = 0; i < 4; ++i) v[rr][i] = ((const float4*)(p.x + (size_t)(row0 + rr) * 1024))[i * 64 + lane];
#pragma unroll
        for (int rr = 0; rr < 2; ++rr) {
            const int row = row0 + rr;
            float ss = 0.f;
#pragma unroll
            for (int i = 0; i < 4; ++i) ss += v[rr][i].x * v[rr][i].x + v[rr][i].y * v[rr][i].y + v[rr][i].z * v[rr][i].z + v[rr][i].w * v[rr][i].w;
            ss = wave_sum(ss);
            const float rstd = rsqrtf(ss * (1.0f / 1024.0f) + EPS);
            float g[8];
#pragma unroll
            for (int j = 0; j < 8; ++j) g[j] = 0.f;
#pragma unroll
            for (int i = 0; i < 4; ++i) {
                const float4 pw = ((const float4*)p.pre_w)[i * 64 + lane];
                float hv[4] = {v[rr][i].x * rstd * pw.x, v[rr][i].y * rstd * pw.y, v[rr][i].z * rstd * pw.z, v[rr][i].w * rstd * pw.w};
                u32x2 w; w.x = cvt_pk_bf16(hv[0], hv[1]); w.y = cvt_pk_bf16(hv[2], hv[3]);
                *(u32x2*)(H + (size_t)row * 1024 + (i * 64 + lane) * 4) = w;
#pragma unroll
                for (int e = 0; e < 4; ++e) {
                    const int k = (i * 64 + lane) * 4 + e;
                    const f32x4 wa = *(const LAS f32x4*)(WG + k * 8), wb = *(const LAS f32x4*)(WG + k * 8 + 4);
                    g[0] += hv[e] * wa[0]; g[1] += hv[e] * wa[1]; g[2] += hv[e] * wa[2]; g[3] += hv[e] * wa[3];
                    g[4] += hv[e] * wb[0]; g[5] += hv[e] * wb[1]; g[6] += hv[e] * wb[2]; g[7] += hv[e] * wb[3];
                }
            }
            const bool h32 = (lane & 32) != 0, h16 = (lane & 16) != 0, h8 = (lane & 8) != 0;
            float t4[4], t2[2];
#pragma unroll
            for (int j = 0; j < 4; ++j) { const float send = h32 ? g[j] : g[j + 4], keep = h32 ? g[j + 4] : g[j]; t4[j] = keep + __shfl_xor(send, 32); }
#pragma unroll
            for (int j = 0; j < 2; ++j) { const float send = h16 ? t4[j] : t4[j + 2], keep = h16 ? t4[j + 2] : t4[j]; t2[j] = keep + __shfl_xor(send, 16); }
            float gt; { const float send = h8 ? t2[0] : t2[1], keep = h8 ? t2[1] : t2[0]; gt = keep + __shfl_xor(send, 8); }
            gt += __shfl_xor(gt, 4); gt += __shfl_xor(gt, 2); gt += __shfl_xor(gt, 1);
            if ((lane & 7) == 0) {
                const int j = (h32 ? 4 : 0) + (h16 ? 2 : 0) + (h8 ? 1 : 0);
                const float gv = gt + bias_l;
                GATES[(size_t)row * 8 + j] = (j < 4) ? gv : (fminf(gv, 0.f) - log1pf(expf(-fabsf(gv))));
            }
        }
    }
    float* RC = (float*)(ws + WS_ROPE); float* RS = RC + 2048 * 16;
    for (int idx = bid * 512 + tid; idx < 2048 * 16; idx += G * 512) {
        const int pos = idx >> 4, i = idx & 15;
        const float inv = powf(500000.0f, -(float)(2 * i) / 32.0f);
        const float ang = (float)pos * inv;
        RC[idx] = cosf(ang); RS[idx] = sinf(ang);
    }
}

constexpr int ML_KB = 0, ML_VT = 67584, ML_WVT = 81920, ML_CT = 96256, ML_G = 124928;
constexpr int KB_STRIDE = 528, VR_STRIDE = 112;

__device__ __forceinline__ void p_conv(const Params& p) {
    const int tid = threadIdx.x;
    const bf16_t* R1 = (const bf16_t*)(p.ws + WS_R1); bf16_t* QK = (bf16_t*)(p.ws + WS_R2);
    const int dvec = tid & 31, rg = tid >> 5; const int s0 = rg * 8;
    for (int tile = blockIdx.x; tile < 1024; tile += gridDim.x) {
        const int cg8 = tile & 7, rt = tile >> 3;
        const int ch = cg8 * 256 + dvec * 8; const int tok0 = rt * 128; const int seq0 = (rt & 15) * 128;
        const float scale = (cg8 >= 4) ? 0.0625f : 1.0f;
        float cw[4][8], cb[8];
#pragma unroll
        for (int w = 0; w < 4; ++w) { const float4 a = *(const float4*)(p.conv_w + w * 2048 + ch), b = *(const float4*)(p.conv_w + w * 2048 + ch + 4);
            cw[w][0] = a.x; cw[w][1] = a.y; cw[w][2] = a.z; cw[w][3] = a.w; cw[w][4] = b.x; cw[w][5] = b.y; cw[w][6] = b.z; cw[w][7] = b.w; }
        { const float4 a = *(const float4*)(p.conv_b + ch), b = *(const float4*)(p.conv_b + ch + 4);
            cb[0] = a.x; cb[1] = a.y; cb[2] = a.z; cb[3] = a.w; cb[4] = b.x; cb[5] = b.y; cb[6] = b.z; cb[7] = b.w; }
        u32x4 raw[11];
#pragma unroll
        for (int i = 0; i < 11; ++i) {
            const int rr = s0 - 3 + i;
            if (seq0 + rr >= 0) raw[i] = __builtin_nontemporal_load((const u32x4*)(R1 + (size_t)(tok0 + rr) * 5120 + ch)); else raw[i] = (u32x4){0u, 0u, 0u, 0u};
        }
#pragma unroll
        for (int i = 0; i < 8; ++i) {
            float o[8];
#pragma unroll
            for (int e = 0; e < 8; ++e) o[e] = cb[e];
#pragma unroll
            for (int w = 0; w < 4; ++w) { float f[8]; unpack8(raw[i + w], f);
#pragma unroll
                for (int e = 0; e < 8; ++e) o[e] += cw[w][e] * f[e]; }
#pragma unroll
            for (int e = 0; e < 8; ++e) o[e] = siluf_(o[e]) * scale;
            st_wt16(QK + (size_t)(tok0 + s0 + i) * 2048 + ch, pack8(o));
        }
    }
}

__device__ __forceinline__ void p2_mlstm(const Params& p, LAS unsigned char* lds) {
    const int tid = threadIdx.x, wid = __builtin_amdgcn_readfirstlane(tid >> 6), lane = tid & 63, r = lane & 15, q = lane >> 4;
    unsigned char* ws = p.ws;
    const bf16_t* R1 = (const bf16_t*)(ws + WS_R1); const bf16_t* QK = (const bf16_t*)(ws + WS_R2);
    const float* GATES = (const float*)(ws + WS_GATES);
    float* SSQ = (float*)(ws + WS_SSQ);
    bf16_t* HM = (bf16_t*)((unsigned char*)p.out + OUT_HM);
    LAS unsigned char* KB = lds + ML_KB; LAS unsigned char* VT = lds + ML_VT; LAS unsigned char* CT = lds + ML_CT; LAS unsigned char* WVT = lds + ML_WVT;
    LAS unsigned char* NV = lds + 149760;
    LAS unsigned char* WV = lds + 150272;
    LAS float* PU = (LAS float*)(lds + ML_G); LAS float* PCM = PU + 2048; LAS float* PB = PU + 4096; LAS float* PBT = PU + 6144; LAS float* PCT = PBT + 16; LAS float* MPREV = PBT + 32; LAS float* MM127 = PBT + 48;
    for (int it = blockIdx.x; it < 256; it += gridDim.x) {
        const int xcd = it & 7, idx = it >> 3; const int bh = xcd * 4 + (idx >> 3), sl = idx & 7; const int b = bh >> 2, h = bh & 3;
        const int tokbase = b * SEQ;
        f32x4 cacc[3][2];
#pragma unroll
        for (int vt = 0; vt < 3; ++vt)
#pragma unroll
            for (int dd = 0; dd < 2; ++dd) cacc[vt][dd] = (f32x4){0.f, 0.f, 0.f, 0.f};
        for (int i = tid; i < (ML_G - ML_VT) / 4; i += 512) ((LAS unsigned*)(lds + ML_VT))[i] = 0u;
#pragma unroll 1
        for (int cc = 0; cc < 2; ++cc) {
            const int ck = 2 * wid + cc; const int t0 = tokbase + ck * 128 + 2 * lane;
            const float ig0 = GATES[(size_t)t0 * 8 + h], lf0 = GATES[(size_t)t0 * 8 + 4 + h], ig1 = GATES[(size_t)(t0 + 1) * 8 + h], lf1 = GATES[(size_t)(t0 + 1) * 8 + 4 + h];
            float sc = lf0 + lf1;
#pragma unroll
            for (int off = 1; off < 64; off <<= 1) { const float t = __shfl_up(sc, off); if (lane >= off) sc += t; }
            const float b1 = sc, b0 = sc - lf1;
            const float u0 = ig0 - b0, u1 = ig1 - b1;
            float cm = fmaxf(u0, u1);
#pragma unroll
            for (int off = 1; off < 64; off <<= 1) { const float t = __shfl_up(cm, off); if (lane >= off) cm = fmaxf(cm, t); }
            float cprev = __shfl_up(cm, 1); if (lane == 0) cprev = -1e30f;
            const int gi = ck * 128 + 2 * lane;
            PU[gi] = u0; PU[gi + 1] = u1; PCM[gi] = fmaxf(cprev, u0); PCM[gi + 1] = cm; PB[gi] = b0; PB[gi + 1] = b1;
            if (lane == 63) { PBT[ck] = b1; PCT[ck] = cm; }
        }
        __syncthreads();
        if (tid < 128) ((LAS unsigned*)NV)[tid] = 0u;
        if (tid == 0) {
            float mprev = 0.f;
#pragma unroll 1
            for (int c = 0; c < 16; ++c) { const float mm = fmaxf(mprev, PCT[c]); MPREV[c] = mprev; MM127[c] = mm; mprev = PBT[c] + mm; }
        }
        u32x4 kreg[8], vreg, qfn[8];
        const unsigned qoff = ((unsigned)(16 * wid + r) * 2048u + (unsigned)(h * 256 + 8 * q)) * 2u;
        const unsigned koff = ((unsigned)(tid >> 5) * 2048u + 1024u + (unsigned)(h * 256) + (unsigned)(tid & 31) * 8u) * 2u;
        const unsigned voff = ((unsigned)(tid >> 2) * 5120u + 2048u + (unsigned)(h * 256 + sl * 32) + (unsigned)(tid & 3) * 8u) * 2u;
        const unsigned ooff = ((unsigned)(16 * wid + r) * 5120u + 3072u + (unsigned)(h * 256 + sl * 32 + 4 * q)) * 2u;
        const unsigned hoff = ((unsigned)(16 * wid + r) * 1024u + (unsigned)(h * 256 + sl * 32 + 4 * q)) * 2u;
        {
            const bf16_t* qkc = QK + (size_t)tokbase * 2048; const bf16_t* r1c = R1 + (size_t)tokbase * 5120;
#pragma unroll
            for (int kk = 0; kk < 8; ++kk) qfn[kk] = ldg16(qkc, qoff + 64u * kk);
#pragma unroll
            for (int i = 0; i < 8; ++i) kreg[i] = ldg16(qkc, koff + 65536u * i);
            vreg = ldg16(r1c, voff);
        }
        __syncthreads();
        for (int chunk = 0; chunk < 16; ++chunk) {
            const int tok0 = tokbase + chunk * 128;
            bf16x8 qf[8];
            {
#pragma unroll
                for (int kk = 0; kk < 8; ++kk) qf[kk] = __builtin_bit_cast(bf16x8, qfn[kk]);
#pragma unroll
                for (int i = 0; i < 8; ++i) { const int vec = tid + 512 * i; *(LAS u32x4*)(KB + (vec >> 5) * KB_STRIDE + (vec & 31) * 16) = kreg[i]; }
                const int s = tid >> 2, vq = tid & 3;
                const float wgt = __expf(PU[chunk * 128 + s] - MM127[chunk]);
                float vf[8]; unpack8(vreg, vf);
#pragma unroll
                for (int e = 0; e < 8; ++e) vf[e] *= wgt;
                *(LAS u32x4*)(VT + s * VR_STRIDE + vq * 16) = vreg;
                *(LAS u32x4*)(WVT + s * VR_STRIDE + vq * 16) = pack8(vf);
                if (vq == 0) *(LAS bf16_t*)(WV + s * 2) = f2bf(wgt);
            }
            __syncthreads();
            u32x2 owr[2], zwr[2];
            {
                const bf16_t* r1c = R1 + (size_t)tok0 * 5120;
#pragma unroll
                for (int vt = 0; vt < 2; ++vt) { owr[vt] = ldg8(r1c, ooff + 32u * vt); zwr[vt] = ldg8(r1c, ooff + 2048u + 32u * vt); }
            }
            const int gl0 = chunk * 128;
            const float mprev = MPREV[chunk], mm127 = MM127[chunk];
            {
                const int l = 16 * wid + r;
                const float mml = fmaxf(mprev, PCM[gl0 + l]);
                f32x4 hacc[3];
                for (int mrep = 0; mrep < MLX2; ++mrep) {
#pragma unroll
                for (int vt = 0; vt < 3; ++vt) hacc[vt] = (f32x4){0.f, 0.f, 0.f, 0.f};
#pragma unroll
                for (int kh = 0; kh < 4; ++kh) {
                    bf16x8 af[2][3];
#pragma unroll
                    for (int k4 = 0; k4 < 2; ++k4)
                    {
#pragma unroll
                        for (int vt = 0; vt < 2; ++vt) {
                            const u32x2 lo = tr_read(CT + (32 * (2 * kh + k4) + 8 * q + (r >> 2)) * VR_STRIDE + (16 * vt + 4 * (r & 3)) * 2);
                            const u32x2 hi = tr_read(CT + (32 * (2 * kh + k4) + 8 * q + 4 + (r >> 2)) * VR_STRIDE + (16 * vt + 4 * (r & 3)) * 2);
                            u32x4 cw; cw.x = lo.x; cw.y = lo.y; cw.z = hi.x; cw.w = hi.y; af[k4][vt] = __builtin_bit_cast(bf16x8, cw);
                        }
                        u32x4 nz = (u32x4){0u, 0u, 0u, 0u};
                        if (r == 0) nz = *(const LAS u32x4*)(NV + (32 * (2 * kh + k4) + 8 * q) * 2);
                        af[k4][2] = __builtin_bit_cast(bf16x8, nz);
                    }
                    __builtin_amdgcn_sched_barrier(0);
#pragma unroll
                    for (int k4 = 0; k4 < 2; ++k4)
#pragma unroll
                        for (int vt = 0; vt < 3; ++vt) hacc[vt] = __builtin_amdgcn_mfma_f32_16x16x32_bf16(af[k4][vt], qf[2 * kh + k4], hacc[vt], 0, 0, 0);
                    __builtin_amdgcn_sched_barrier(0);
                }
                const float inter = __expf(mprev - mml);
#pragma unroll
                for (int vt = 0; vt < 3; ++vt) hacc[vt] *= inter;
                {
                    const int nb = 4 * ((wid >> 1) + 1);
                    bf16x8 fa0[2], fa1[2], fb0[2], fb1[2];
#define ML_LDB(d0, d1, bb) do { _Pragma("unroll") for (int k4 = 0; k4 < 2; ++k4) { \
                        d0[k4] = *(const LAS bf16x8*)(KB + (32 * ((bb) >> 2) + r) * KB_STRIDE + (32 * (2 * ((bb) & 3) + k4) + 8 * q) * 2); \
                        d1[k4] = *(const LAS bf16x8*)(KB + (32 * ((bb) >> 2) + 16 + r) * KB_STRIDE + (32 * (2 * ((bb) & 3) + k4) + 8 * q) * 2); } } while (0)
                    ML_LDB(fa0, fa1, 0);
                    f32x4 s0 = (f32x4){0.f, 0.f, 0.f, 0.f}, s1 = s0;
#pragma unroll
                    for (int bb = 0; bb < 16; ++bb) {
                        if (bb < nb) {
                            if (bb + 1 < nb) { if (bb & 1) ML_LDB(fa0, fa1, bb + 1); else ML_LDB(fb0, fb1, bb + 1); }
                            __builtin_amdgcn_sched_barrier(0);
#pragma unroll
                            for (int k4 = 0; k4 < 2; ++k4) {
                                s0 = __builtin_amdgcn_mfma_f32_16x16x32_bf16((bb & 1) ? fb0[k4] : fa0[k4], qf[2 * (bb & 3) + k4], s0, 0, 0, 0);
                                s1 = __builtin_amdgcn_mfma_f32_16x16x32_bf16((bb & 1) ? fb1[k4] : fa1[k4], qf[2 * (bb & 3) + k4], s1, 0, 0, 0);
                            }
                            __builtin_amdgcn_sched_barrier(0);
                            if ((bb & 3) == 3) {
                                const int sp = bb >> 2;
                                const f32x4 u0 = *(const LAS f32x4*)(PU + gl0 + 32 * sp + 4 * q), u1 = *(const LAS f32x4*)(PU + gl0 + 32 * sp + 16 + 4 * q);
                                if (2 * sp < wid) {
#pragma unroll
                                    for (int j = 0; j < 4; ++j) s0[j] *= __expf(u0[j] - mml);
                                } else {
#pragma unroll
                                    for (int j = 0; j < 4; ++j) s0[j] = (4 * q + j <= r) ? s0[j] * __expf(u0[j] - mml) : 0.f;
                                }
                                if (2 * sp + 1 < wid) {
#pragma unroll
                                    for (int j = 0; j < 4; ++j) s1[j] *= __expf(u1[j] - mml);
                                } else if (2 * sp + 1 == wid) {
#pragma unroll
                                    for (int j = 0; j < 4; ++j) s1[j] = (4 * q + j <= r) ? s1[j] * __expf(u1[j] - mml) : 0.f;
                                } else {
                                    s1 = (f32x4){0.f, 0.f, 0.f, 0.f};
                                }
                                u32x4 bw; bw.x = cvt_pk_bf16(s0[0], s0[1]); bw.y = cvt_pk_bf16(s0[2], s0[3]); bw.z = cvt_pk_bf16(s1[0], s1[1]); bw.w = cvt_pk_bf16(s1[2], s1[3]);
                                const bf16x8 bfrag = __builtin_bit_cast(bf16x8, bw);
#pragma unroll
                                for (int vt = 0; vt < 2; ++vt) {
                                    const u32x2 lo = tr_read(VT + (32 * sp + 4 * q + (r >> 2)) * VR_STRIDE + (16 * vt + 4 * (r & 3)) * 2);
                                    const u32x2 hi = tr_read(VT + (32 * sp + 16 + 4 * q + (r >> 2)) * VR_STRIDE + (16 * vt + 4 * (r & 3)) * 2);
                                    u32x4 aw; aw.x = lo.x; aw.y = lo.y; aw.z = hi.x; aw.w = hi.y;
                                    hacc[vt] = __builtin_amdgcn_mfma_f32_16x16x32_bf16(__builtin_bit_cast(bf16x8, aw), bfrag, hacc[vt], 0, 0, 0);
                                }
                                { const unsigned one2 = (r == 0) ? 0x3F803F80u : 0u; const u32x4 ow = (u32x4){one2, one2, one2, one2};
                                  hacc[2] = __builtin_amdgcn_mfma_f32_16x16x32_bf16(__builtin_bit_cast(bf16x8, ow), bfrag, hacc[2], 0, 0, 0); }
                                s0 = (f32x4){0.f, 0.f, 0.f, 0.f}; s1 = s0;
                            }
                        }
                    }
#undef ML_LDB
                }
                }
                const float den = __shfl(hacc[2][0], r);
                const float dn = fmaxf(fabsf(den), __expf(-(PB[gl0 + l] + mml)));
                const float rdn = 1.0f / dn;
                const int t = tok0 + l;
                float ssq = 0.f;
#pragma unroll
                for (int vt = 0; vt < 2; ++vt) {
                    const int c = h * 256 + sl * 32 + 16 * vt + 4 * q;
                    const u32x2 ow = owr[vt], zw = zwr[vt];
                    const float4 nw = *(const float4*)(p.m_norm_w + c);
                    const float og[4] = {bflo(ow.x), bfhi(ow.x), bflo(ow.y), bfhi(ow.y)};
                    const float zg[4] = {bflo(zw.x), bfhi(zw.x), bflo(zw.y), bfhi(zw.y)};
                    const float nwv[4] = {nw.x, nw.y, nw.z, nw.w};
                    float uo[4];
#pragma unroll
                    for (int j = 0; j < 4; ++j) { const float hs = hacc[vt][j] * rdn * sigmoidf_(og[j]); ssq += hs * hs; uo[j] = hs * nwv[j] * siluf_(zg[j]); }
                    u32x2 w; w.x = cvt_pk_bf16(uo[0], uo[1]); w.y = cvt_pk_bf16(uo[2], uo[3]);
                    stg8(HM + (size_t)tok0 * 1024, hoff + 32u * vt, w);
                }
                ssq += __shfl_xor(ssq, 16); ssq += __shfl_xor(ssq, 32);
                if (q == 0) SSQ[((size_t)t * 4 + h) * 8 + sl] = ssq;
                if (chunk < 15) {
                    const bf16_t* qkc = QK + (size_t)(tok0 + 128) * 2048; const bf16_t* r1c = R1 + (size_t)(tok0 + 128) * 5120;
#pragma unroll
                    for (int kk = 0; kk < 8; ++kk) qfn[kk] = ldg16(qkc, qoff + 64u * kk);
#pragma unroll
                    for (int i = 0; i < 8; ++i) kreg[i] = ldg16(qkc, koff + 65536u * i);
                    vreg = ldg16(r1c, voff);
                }

                const float decay = __expf(mprev - mm127);
#pragma unroll
                for (int vt = 0; vt < 3; ++vt)
#pragma unroll
                    for (int dd = 0; dd < 2; ++dd) cacc[vt][dd] *= decay;
#pragma unroll
                for (int kk = 0; kk < 4; ++kk) {
                    bf16x8 kb[2], wa[3];
#pragma unroll
                    for (int dd = 0; dd < 2; ++dd) {
                        const u32x2 lo = tr_read(KB + (32 * kk + 8 * q + (r >> 2)) * KB_STRIDE + (16 * (2 * wid + dd) + 4 * (r & 3)) * 2);
                        const u32x2 hi = tr_read(KB + (32 * kk + 8 * q + 4 + (r >> 2)) * KB_STRIDE + (16 * (2 * wid + dd) + 4 * (r & 3)) * 2);
                        u32x4 kw; kw.x = lo.x; kw.y = lo.y; kw.z = hi.x; kw.w = hi.y; kb[dd] = __builtin_bit_cast(bf16x8, kw);
                    }
#pragma unroll
                    for (int vt = 0; vt < 2; ++vt) {
                        const u32x2 lo = tr_read(WVT + (32 * kk + 8 * q + (r >> 2)) * VR_STRIDE + (16 * vt + 4 * (r & 3)) * 2);
                        const u32x2 hi = tr_read(WVT + (32 * kk + 8 * q + 4 + (r >> 2)) * VR_STRIDE + (16 * vt + 4 * (r & 3)) * 2);
                        u32x4 ww; ww.x = lo.x; ww.y = lo.y; ww.z = hi.x; ww.w = hi.y; wa[vt] = __builtin_bit_cast(bf16x8, ww);
                    }
                    { u32x4 wz = (u32x4){0u, 0u, 0u, 0u}; if (r == 0) wz = *(const LAS u32x4*)(WV + (32 * kk + 8 * q) * 2); wa[2] = __builtin_bit_cast(bf16x8, wz); }
                    __builtin_amdgcn_sched_barrier(0);
#pragma unroll
                    for (int vt = 0; vt < 3; ++vt)
#pragma unroll
                        for (int dd = 0; dd < 2; ++dd) cacc[vt][dd] = __builtin_amdgcn_mfma_f32_16x16x32_bf16(wa[vt], kb[dd], cacc[vt][dd], 0, 0, 0);
                    __builtin_amdgcn_sched_barrier(0);
                }
            }
            __syncthreads();
#pragma unroll
            for (int vt = 0; vt < 2; ++vt)
#pragma unroll
                for (int dd = 0; dd < 2; ++dd)
                    { u32x2 cw; cw.x = cvt_pk_bf16(cacc[vt][dd][0], cacc[vt][dd][1]); cw.y = cvt_pk_bf16(cacc[vt][dd][2], cacc[vt][dd][3]);
                      *(LAS u32x2*)(CT + (16 * (2 * wid + dd) + r) * VR_STRIDE + (16 * vt + 4 * q) * 2) = cw; }
            if (q == 0) {
#pragma unroll
                for (int dd = 0; dd < 2; ++dd) *(LAS bf16_t*)(NV + (16 * (2 * wid + dd) + r) * 2) = f2bf(cacc[2][dd][0]);
            }
        }
        __syncthreads();
    }
}

constexpr int AT_KA = 0, AT_VB = 69632;
constexpr int KA_STRIDE = 272, VB_STRIDE = 288;
struct AttnItem { int b, g, hh, blk, rr, dil; };
__device__ __forceinline__ AttnItem attn_item(int it) {
    AttnItem a; const int sub = it & 15; a.hh = (it >> 4) & 3; a.g = (it >> 6) % 3; a.b = it / 192;
    const int lg = 2 * a.g; a.dil = 1 << lg; const int nblk = 16 >> lg; a.blk = sub & (nblk - 1); a.rr = sub >> (4 - lg); return a;
}
__device__ __forceinline__ void attn_load(const bf16_t* R1, const AttnItem& a, int tid, u32x4 (&kr)[8], u32x4 (&vr)[8]) {
    const int lg = 2 * a.g;
    const size_t seq = (size_t)a.g * ((size_t)T_TOK * 512) + (size_t)((((a.b * 4 + a.hh) << lg) + a.rr) * (2048 >> lg)) * 128;
    const bf16_t* Kq = (const bf16_t*)((const unsigned char*)R1 + R1_KA) + seq; const bf16_t* Vq = (const bf16_t*)((const unsigned char*)R1 + R1_VA) + seq;
    const int row = tid >> 1, pv = tid & 1; const int jk = a.blk * 128 - 128 + row;
    const u32x4 z = (u32x4){0u, 0u, 0u, 0u};
    if (jk >= 0) { const bf16_t* src = Kq + (size_t)jk * 128; kr[0] = *(const u32x4*)(src + 8 * pv); kr[1] = *(const u32x4*)(src + 16 + 8 * pv); } else { kr[0] = z; kr[1] = z; }
#pragma unroll
    for (int i = 0; i < 6; ++i) {
        const int task = tid + 512 * i; const int row2 = task / 12, v = 4 + task % 12; const int jk2 = a.blk * 128 - 128 + row2;
        kr[2 + i] = (jk2 >= 0) ? *(const u32x4*)(Kq + (size_t)jk2 * 128 + v * 8) : z;
    }
#pragma unroll
    for (int vi = 0; vi < 8; ++vi) vr[vi] = (jk >= 0) ? *(const u32x4*)(Vq + (size_t)jk * 128 + pv * 64 + vi * 8) : z;
}
__device__ __forceinline__ void p4_attn(const Params& p, LAS unsigned char* lds, const int dummy) {
    const int tid = threadIdx.x, wid = __builtin_amdgcn_readfirstlane(tid >> 6), lane = tid & 63, r = lane & 15, q = lane >> 4;
    unsigned char* ws = p.ws;
    bf16_t* R1 = (bf16_t*)(ws + WS_R1);
    const float* RC = (const float*)(ws + WS_ROPE); const float* RS = RC + 2048 * 16;
    float* ML = (float*)((unsigned char*)p.out + OUT_ML);
    LAS unsigned char* KA = lds + AT_KA; LAS unsigned char* VB = lds + AT_VB;
    const float QSCALE = 0.08838834764831845f * 1.4426950408889634f;
    u32x4 kr[8], vr[8];
    int it = blockIdx.x;
    if (it < 1536) { const AttnItem a0 = attn_item(it); attn_load(R1, a0, tid, kr, vr); }
    for (; it < 1536; it += gridDim.x) {
        const AttnItem a = attn_item(it);
        const int blk = a.blk, dil = a.dil, rr = a.rr, g = a.g, hh = a.hh;
        const int tokb = a.b * SEQ; const int qcol = g * 512 + hh * 128;
        {
            const int row = tid >> 1, pv = tid & 1; const int jk = blk * 128 - 128 + row;
            u32x4 o1 = kr[0], o2 = kr[1];
            if (jk >= 0) {
                const int pos = jk * dil + rr;
                float x1[8], x2[8]; unpack8(kr[0], x1); unpack8(kr[1], x2);
                const float4 ca = *(const float4*)(RC + pos * 16 + 8 * pv), cb = *(const float4*)(RC + pos * 16 + 8 * pv + 4);
                const float4 sa = *(const float4*)(RS + pos * 16 + 8 * pv), sb = *(const float4*)(RS + pos * 16 + 8 * pv + 4);
                const float cc[8] = {ca.x, ca.y, ca.z, ca.w, cb.x, cb.y, cb.z, cb.w}, sn[8] = {sa.x, sa.y, sa.z, sa.w, sb.x, sb.y, sb.z, sb.w};
                float y1[8], y2[8];
#pragma unroll
                for (int e = 0; e < 8; ++e) { y1[e] = x1[e] * cc[e] - x2[e] * sn[e]; y2[e] = x2[e] * cc[e] + x1[e] * sn[e]; }
                o1 = pack8(y1); o2 = pack8(y2);
            }
            *(LAS u32x4*)(KA + row * KA_STRIDE + (8 * pv) * 2) = o1;
            *(LAS u32x4*)(KA + row * KA_STRIDE + (16 + 8 * pv) * 2) = o2;
#pragma unroll
            for (int i = 0; i < 6; ++i) { const int task = tid + 512 * i; const int row2 = task / 12, v = 4 + task % 12; *(LAS u32x4*)(KA + row2 * KA_STRIDE + v * 16) = kr[2 + i]; }
#pragma unroll
            for (int vi = 0; vi < 8; ++vi) *(LAS u32x4*)(VB + row * VB_STRIDE + (pv * 64 + vi * 8) * 2) = vr[vi];
        }
        const int ql = 16 * wid + r; const int jq = blk * 128 + ql; const int posq = jq * dil + rr; const size_t tq = (size_t)(tokb + posq);
        bf16x8 qf[4];
        {
            bf16_t* qsrc = R1 + tq * QZ_LD + qcol;
#pragma unroll
            for (int kk = 0; kk < 4; ++kk) {
                const u32x4 av = *(const u32x4*)(qsrc + 32 * kk + 8 * q);
                float x[8]; unpack8(av, x);
                if (kk == 0) {
                    const int fi = 8 * (q & 1);
                    const float4 ca = *(const float4*)(RC + posq * 16 + fi), cb = *(const float4*)(RC + posq * 16 + fi + 4);
                    const float4 sa = *(const float4*)(RS + posq * 16 + fi), sb = *(const float4*)(RS + posq * 16 + fi + 4);
                    const float cc[8] = {ca.x, ca.y, ca.z, ca.w, cb.x, cb.y, cb.z, cb.w}, sn[8] = {sa.x, sa.y, sa.z, sa.w, sb.x, sb.y, sb.z, sb.w};
#pragma unroll
                    for (int e = 0; e < 8; ++e) { const float xo = __shfl_xor(x[e], 32); x[e] = (q < 2) ? (x[e] * cc[e] - xo * sn[e]) : (x[e] * cc[e] + xo * sn[e]); }
                }
#pragma unroll
                for (int e = 0; e < 8; ++e) x[e] *= QSCALE;
                qf[kk] = __builtin_bit_cast(bf16x8, pack8(x));
            }
        }
        __syncthreads();
        if (it + (int)gridDim.x < 1536) { const AttnItem an = attn_item(it + gridDim.x); attn_load(R1, an, tid, kr, vr); }
        const int ilo = (blk == 0) ? 8 - wid : 0;
        f32x4 sT[9];
#pragma unroll
        for (int i = 0; i < 9; ++i) sT[i] = (f32x4){0.f, 0.f, 0.f, 0.f};
#pragma unroll
        for (int gi = 0; gi < 3; ++gi) {
            if (3 * gi + 2 >= ilo) {
                bf16x8 ka[3][4];
#pragma unroll
                for (int i3 = 0; i3 < 3; ++i3)
#pragma unroll
                    for (int kk = 0; kk < 4; ++kk) ka[i3][kk] = *(const LAS bf16x8*)(KA + (16 * (wid + 3 * gi + i3) + r) * KA_STRIDE + (32 * kk + 8 * q) * 2);
                __builtin_amdgcn_sched_barrier(0);
#pragma unroll
                for (int kk = 0; kk < 4; ++kk)
#pragma unroll
                    for (int i3 = 0; i3 < 3; ++i3) sT[3 * gi + i3] = __builtin_amdgcn_mfma_f32_16x16x32_bf16(ka[i3][kk], qf[kk], sT[3 * gi + i3], 0, 0, 0);
                __builtin_amdgcn_sched_barrier(0);
            }
        }
        float mx = -1e30f;
#pragma unroll
        for (int i = 0; i < 9; ++i)
#pragma unroll
            for (int j = 0; j < 4; ++j) {
                const int kl = 16 * (wid + i) + 4 * q + j; const int dist = ql - kl + 128; const int jk = blk * 128 - 128 + kl;
                const bool valid = (dist >= 0) && (dist <= 128) && (jk >= 0);
                sT[i][j] = valid ? sT[i][j] : -1e30f; mx = fmaxf(mx, sT[i][j]);
            }
        mx = fmaxf(mx, __shfl_xor(mx, 16)); mx = fmaxf(mx, __shfl_xor(mx, 32));
        float lsum = 0.f;
#pragma unroll
        for (int i = 0; i < 9; ++i)
#pragma unroll
            for (int j = 0; j < 4; ++j) { const float pe = (sT[i][j] > -1e29f) ? exp2f(sT[i][j] - mx) : 0.f; sT[i][j] = pe; lsum += pe; }
        lsum += __shfl_xor(lsum, 16); lsum += __shfl_xor(lsum, 32);
        f32x4 oacc[8];
#pragma unroll
        for (int et = 0; et < 8; ++et) oacc[et] = (f32x4){0.f, 0.f, 0.f, 0.f};
#pragma unroll
        for (int ps = 0; ps < 5; ++ps) {
            if (2 * ps + 1 >= ilo) {
                u32x4 bw; bw.x = cvt_pk_bf16(sT[2 * ps][0], sT[2 * ps][1]); bw.y = cvt_pk_bf16(sT[2 * ps][2], sT[2 * ps][3]);
                if (ps < 4) { bw.z = cvt_pk_bf16(sT[(2 * ps + 1) % 9][0], sT[(2 * ps + 1) % 9][1]); bw.w = cvt_pk_bf16(sT[(2 * ps + 1) % 9][2], sT[(2 * ps + 1) % 9][3]); } else { bw.z = 0u; bw.w = 0u; }
                const bf16x8 bfrag = __builtin_bit_cast(bf16x8, bw);
                u32x2 vlo[8], vhi[8];
#pragma unroll
                for (int et = 0; et < 8; ++et) {
                    vlo[et] = tr_read(VB + (16 * (wid + 2 * ps) + 4 * q + (r >> 2)) * VB_STRIDE + (16 * et + 4 * (r & 3)) * 2);
                    vhi[et] = (u32x2){0u, 0u};
                    if (ps < 4) vhi[et] = tr_read(VB + (16 * (wid + 2 * ps + 1) + 4 * q + (r >> 2)) * VB_STRIDE + (16 * et + 4 * (r & 3)) * 2);
                }
                __builtin_amdgcn_sched_barrier(0);
#pragma unroll
                for (int et = 0; et < 8; ++et) {
                    u32x4 aw; aw.x = vlo[et].x; aw.y = vlo[et].y; aw.z = vhi[et].x; aw.w = vhi[et].y;
                    oacc[et] = __builtin_amdgcn_mfma_f32_16x16x32_bf16(__builtin_bit_cast(bf16x8, aw), bfrag, oacc[et], 0, 0, 0);
                }
                __builtin_amdgcn_sched_barrier(0);
            }
        }
        const float rl = 1.0f / lsum;
        {
            bf16_t* odst = dummy ? (bf16_t*)((unsigned char*)p.out + 8388608 + ((tq * 1536 + qcol) * 2 & 16777215)) : R1 + tq * QZ_LD + qcol;
#pragma unroll
            for (int et = 0; et < 8; ++et) {
                u32x2 w; w.x = cvt_pk_bf16(oacc[et][0] * rl, oacc[et][1] * rl); w.y = cvt_pk_bf16(oacc[et][2] * rl, oacc[et][3] * rl);
                *(u32x2*)(odst + 16 * et + 4 * q) = w;
            }
            if (q == 0) { float2 mlv; mlv.x = mx; mlv.y = lsum; *(float2*)(ML + (tq * 12 + g * 4 + hh) * 2) = mlv; }
        }
        __syncthreads();
    }
}

__device__ __forceinline__ void p5_fixup(const Params& p) {
    const int tid = threadIdx.x, G = gridDim.x, bid = blockIdx.x;
    unsigned char* ws = p.ws;
    const bf16_t* R1 = (const bf16_t*)(ws + WS_R1);
    const float* SSQ = (const float*)(ws + WS_SSQ);
    bf16_t* HM = (bf16_t*)((unsigned char*)p.out + OUT_HM);
    const float* ML = (const float*)((unsigned char*)p.out + OUT_ML);
    bf16_t* ATT = (bf16_t*)((unsigned char*)p.out + OUT_ATT);
    const int gtid = bid * 512 + tid, gsz = G * 512;
    for (int v0 = gtid; v0 < T_TOK * 128; v0 += 4 * gsz) {
        u32x4 hv[4]; float4 s0[4], s1[4];
#pragma unroll
        for (int u = 0; u < 4; ++u) { const int v = v0 + u * gsz; if (v < T_TOK * 128) { const int row = v >> 7, head = (v >> 5) & 3;
            hv[u] = __builtin_nontemporal_load((const u32x4*)(HM + (size_t)v * 8)); s0[u] = *(const float4*)(SSQ + ((size_t)row * 4 + head) * 8); s1[u] = *(const float4*)(SSQ + ((size_t)row * 4 + head) * 8 + 4); } }
#pragma unroll
        for (int u = 0; u < 4; ++u) { const int v = v0 + u * gsz; if (v < T_TOK * 128) {
            const float ss = (s0[u].x + s0[u].y) + (s0[u].z + s0[u].w) + (s1[u].x + s1[u].y) + (s1[u].z + s1[u].w);
            const float rstd = rsqrtf(ss * (1.0f / 256.0f) + EPS);
            float f[8]; unpack8(hv[u], f);
#pragma unroll
            for (int e = 0; e < 8; ++e) f[e] *= rstd;
            st_wt16(HM + (size_t)v * 8, pack8(f)); } }
    }
    for (int v0 = gtid; v0 < T_TOK * 64; v0 += 2 * gsz) {
        u32x4 ov[2][3], zv[2]; float2 ml[2][3];
#pragma unroll
        for (int u = 0; u < 2; ++u) { const int v = v0 + u * gsz; if (v < T_TOK * 64) { const int row = v >> 6, cv = v & 63, hs = cv >> 4;
#pragma unroll
            for (int g = 0; g < 3; ++g) { ml[u][g] = *(const float2*)(ML + ((size_t)row * 12 + g * 4 + hs) * 2); ov[u][g] = __builtin_nontemporal_load((const u32x4*)(R1 + (size_t)row * QZ_LD + g * 512 + cv * 8)); }
            zv[u] = __builtin_nontemporal_load((const u32x4*)(R1 + (size_t)row * QZ_LD + 1536 + cv * 8)); } }
#pragma unroll
        for (int u = 0; u < 2; ++u) { const int v = v0 + u * gsz; if (v < T_TOK * 64) {
            const float M = fmaxf(ml[u][0].x, fmaxf(ml[u][1].x, ml[u][2].x));
            float wt[3], W = 0.f;
#pragma unroll
            for (int g = 0; g < 3; ++g) { wt[g] = exp2f(ml[u][g].x - M) * ml[u][g].y; W += wt[g]; }
            const float rW = 1.0f / W;
            float acc[8];
#pragma unroll
            for (int e = 0; e < 8; ++e) acc[e] = 0.f;
#pragma unroll
            for (int g = 0; g < 3; ++g) { float f[8]; unpack8(ov[u][g], f);
#pragma unroll
                for (int e = 0; e < 8; ++e) acc[e] += wt[g] * f[e]; }
            float z[8]; unpack8(zv[u], z);
#pragma unroll
            for (int e = 0; e < 8; ++e) acc[e] = acc[e] * rW * siluf_(z[e]);
            st_wt16(ATT + (size_t)v * 8, pack8(acc)); } }
    }
}

__device__ __forceinline__ void p8_final(const Params& p) {
    const int tid = threadIdx.x, G = gridDim.x, bid = blockIdx.x, lane = tid & 63, wid = tid >> 6;
    const float* Y = (const float*)(p.ws + WS_R1 + R1_Y);
    for (int row = bid * 8 + wid; row < T_TOK; row += G * 8) {
        const float4* yr = (const float4*)(Y + (size_t)row * 1024); const float4* xr = (const float4*)(p.x + (size_t)row * 1024);
        float4 v[4]; float ss = 0.f;
#pragma unroll
        for (int i = 0; i < 4; ++i) { v[i] = yr[i * 64 + lane]; ss += v[i].x * v[i].x + v[i].y * v[i].y + v[i].z * v[i].z + v[i].w * v[i].w; }
        ss = wave_sum(ss);
        const float rstd = rsqrtf(ss * (1.0f / 1024.0f) + EPS);
#pragma unroll
        for (int i = 0; i < 4; ++i) {
            const float4 pw = ((const float4*)p.post_w)[i * 64 + lane]; const float4 xv = xr[i * 64 + lane];
            float4 o; o.x = xv.x + v[i].x * rstd * pw.x; o.y = xv.y + v[i].y * rstd * pw.y; o.z = xv.z + v[i].z * rstd * pw.z; o.w = xv.w + v[i].w * rstd * pw.w;
            ((float4*)(p.out + (size_t)row * 1024))[i * 64 + lane] = o;
        }
    }
}

__global__ void __launch_bounds__(512, 2) mega_fwd(Params p) {
    extern __shared__ __attribute__((aligned(16))) unsigned char lds_raw[];
    LAS unsigned char* lds = (LAS unsigned char*)lds_raw;
    cg::grid_group grid = cg::this_grid();
    const int lo = p.ph_lo, hi = p.ph_hi;
    unsigned char* ws = p.ws;
    const int G = gridDim.x, bid = blockIdx.x;
#define IN(k) (lo <= (k) && (k) < hi)
    if (threadIdx.x == 0) { ((volatile LAS unsigned*)(lds + LDS_BAR_OFF))[0] = 0u; ((volatile LAS unsigned*)(lds + LDS_BAR_OFF))[1] = 0u; }
    __syncthreads();
    XcdBarrier xbar; xbar.bar = (unsigned*)(ws + WS_BAR); xbar.x = 0; xbar.st = nullptr;
    if (hi - lo > 1) xbar = xcd_barrier_post((unsigned*)(ws + WS_BAR), (volatile LAS unsigned*)(lds + LDS_BAR_OFF));
#define SEAM(k) do { if (IN(k) && IN((k) + 1)) { xcd_barrier(xbar); if (REPB > 1) xcd_barrier(xbar); } } while (0)
    if (lo > 1000) grid.sync();
    bf16_t* H = (bf16_t*)((unsigned char*)p.out + OUT_H);
    bf16_t* HM = (bf16_t*)((unsigned char*)p.out + OUT_HM);
    bf16_t* ATT = (bf16_t*)((unsigned char*)p.out + OUT_ATT);
    bf16_t* WinT = (bf16_t*)(ws + WS_WIN);
    bf16_t* R1 = (bf16_t*)(ws + WS_R1); bf16_t* R2 = (bf16_t*)(ws + WS_R2);
    if (IN(0)) { for (int rep = 0; rep < REP0; ++rep) p0_prep(p, lds); }
    SEAM(0);
    if (IN(1)) {
        pg8::Gemm g{H, WinT, T_TOK, 5120, 1024}; pg8::StaticOrder S; S.init(T_TOK, 5120, G, bid);
        EpiStoreBf16 E{R1, 5120, 1 << 30, R1, 5120};
        for (int rep = 0; rep < REP1; ++rep) pg8::gemm_phase<EpiStoreBf16>(lds, g, S, E);
    }
    SEAM(1);
    if (IN(2)) { for (int rep = 0; rep < REPC; ++rep) p_conv(p); }
    SEAM(2);
    if (IN(3)) { for (int rep = 0; rep < REP2; ++rep) p2_mlstm(p, lds); }
    SEAM(3);
    if (IN(4)) {
        pg8::Gemm g{H, WinT + (size_t)5120 * 1024, T_TOK, 7168, 1024}; pg8::StaticOrder S; S.init(T_TOK, 7168, G, bid);
        EpiProjB E{R1, (bf16_t*)(ws + WS_R1 + R1_KA), (bf16_t*)(ws + WS_R1 + R1_VA), R2};
        for (int rep = 0; rep < REP4; ++rep) pg8::gemm_phase<EpiProjB>(lds, g, S, E);
    }
    SEAM(4);
    if (IN(5)) { for (int rep = 0; rep < REPA; ++rep) p4_attn(p, lds, rep < REPA - 1); }
    SEAM(5);
    if (IN(6)) { p5_fixup(p); }
    SEAM(6);
    if (IN(7)) {
        bf16_t* MG = (bf16_t*)(ws + WS_R1 + R1_MG);
        pg8::Gemm g0{HM, (const bf16_t*)(ws + WS_WPM), T_TOK, 1024, 1024}; pg8::Gemm g1{ATT, (const bf16_t*)(ws + WS_WPA), T_TOK, 1024, 512};
        pg8::StaticOrder S; S.init(T_TOK, 1024, G, bid);
        EpiRatio E0{R2}; EpiMerge2 E1{R2, MG};
        pg8::gemm_phase2<EpiRatio, EpiMerge2>(lds, g0, g1, S, E0, E1);
    }
    SEAM(7);
    const bool fuse_out = (G == 256);
    if (IN(8)) {
        pg8::Gemm g{(const bf16_t*)(ws + WS_R1 + R1_MG), (const bf16_t*)(ws + WS_WOUT), T_TOK, 1024, 1024}; pg8::StaticOrder S; S.init(T_TOK, 1024, G, bid);
        if (fuse_out) { EpiRmsRes E{p.x, p.post_w, p.out, (float*)(ws + WS_R2), (unsigned*)(ws + WS_BAR) + 3600}; pg8::gemm_phase<EpiRmsRes, true>(lds, g, S, E); }
        else { EpiF32 E{(float*)(ws + WS_R1 + R1_Y)}; pg8::gemm_phase<EpiF32>(lds, g, S, E); }
    }
    if (!fuse_out) {
        SEAM(8);
        if (IN(9)) { for (int rep = 0; rep < REP8; ++rep) p8_final(p); }
    }
}

extern "C" void kernel_launch(void* const* d_in, const int* in_sizes, int n_in, void* d_out, int out_size, void* d_ws, size_t ws_size, hipStream_t stream) {
    static int grid = 0;
    if (grid == 0) {
        int dev = 0, cus = 0, per_cu = 0;
        (void)hipGetDevice(&dev);
        (void)hipDeviceGetAttribute(&cus, hipDeviceAttributeMultiprocessorCount, dev);
        (void)hipFuncSetAttribute((const void*)mega_fwd, hipFuncAttributeMaxDynamicSharedMemorySize, LDS_BYTES);
        (void)hipOccupancyMaxActiveBlocksPerMultiprocessor(&per_cu, (const void*)mega_fwd, 512, LDS_BYTES);
        (void)hipGetLastError();
        if (per_cu < 1) per_cu = 1;
        if (per_cu > 1) per_cu = 1;
        grid = cus * per_cu;
        if (ws_size < WS_END) fprintf(stderr, "kernel_launch: workspace too small: %zu < %zu\n", ws_size, (size_t)WS_END);
    }
    Params p{};
    p.x = (const float*)d_in[0]; p.pre_w = (const float*)d_in[1]; p.w_in = (const float*)d_in[2]; p.b_if = (const float*)d_in[3];
    p.conv_w = (const float*)d_in[4]; p.conv_b = (const float*)d_in[5]; p.m_norm_w = (const float*)d_in[6]; p.w_pm = (const float*)d_in[7];
    p.w_pa = (const float*)d_in[8]; p.w_out = (const float*)d_in[9]; p.post_w = (const float*)d_in[10];
    p.out = (float*)d_out; p.ws = (unsigned char*)d_ws; p.ph_lo = 0; p.ph_hi = 10;
    (void)hipMemsetAsync((unsigned char*)d_ws + WS_BAR, 0, 16384, stream);
    void* args[] = {&p};
    hipError_t e = hipLaunchCooperativeKernel((const void*)mega_fwd, dim3(grid), dim3(512), args, LDS_BYTES, stream);
    if (e != hipSuccess) fprintf(stderr, "cooperative launch failed: %s (grid %d)\n", hipGetErrorString(e), grid);
}
```

```cpp
#include <hip/hip_runtime.h>
#include <hip/hip_cooperative_groups.h>
#include <cstdio>
namespace cg = cooperative_groups;

#define LAS __attribute__((address_space(3)))
typedef unsigned short bf16_t;
typedef short bf16x8 __attribute__((ext_vector_type(8)));
typedef float f32x4 __attribute__((ext_vector_type(4)));
typedef unsigned u32x4 __attribute__((ext_vector_type(4)));
typedef unsigned u32x2 __attribute__((ext_vector_type(2)));

constexpr int T_TOK = 16384, DM = 1024, SEQ = 2048, INW = 12296;
constexpr int LDS_BAR_OFF = 150784;
constexpr int LDS_BYTES = 150800;
#ifndef REP0
#define REP0 1
#endif
#ifndef REP1
#define REP1 1
#endif
#ifndef REP2
#define REP2 1
#endif
#ifndef REP8
#define REP8 1
#endif
#ifndef REPA
#define REPA 1
#endif
#ifndef REPB
#define REPB 1
#endif
#ifndef REP4
#define REP4 1
#endif
#ifndef MLX2
#define MLX2 1
#endif
#ifndef REPC
#define REPC 1
#endif
#ifndef REP7
#define REP7 1
#endif
constexpr float EPS = 1e-6f;
constexpr size_t WS_WIN = 0;
constexpr size_t WS_WPM = 25165824;
constexpr size_t WS_WPA = WS_WPM + 2097152;
constexpr size_t WS_WOUT = WS_WPA + 1048576;
constexpr size_t WS_GATES = WS_WOUT + 2097152;
constexpr size_t WS_R1 = WS_GATES + 524288;
constexpr size_t WS_R2 = WS_R1 + 167772160;
constexpr size_t WS_SSQ = WS_R2 + 67108864;
constexpr size_t WS_ROPE = WS_SSQ + 2097152;
constexpr size_t WS_BAR = WS_ROPE + 262144;
constexpr size_t WS_END = WS_BAR + 16384;
constexpr size_t OUT_H = 0, OUT_HM = 33554432, OUT_ML = 0, OUT_ATT = 4194304;
constexpr size_t R1_KA = 67108864, R1_VA = R1_KA + 50331648;
constexpr int QZ_LD = 2048;
constexpr size_t R1_TMP = 0, R1_MG = 67108864, R1_Y = 100663296;

struct Params {
    const float* x; const float* pre_w; const float* w_in; const float* b_if; const float* conv_w; const float* conv_b;
    const float* m_norm_w; const float* w_pm; const float* w_pa; const float* w_out; const float* post_w;
    float* out; unsigned char* ws; int ph_lo, ph_hi;
};

__device__ __forceinline__ float bf2f(unsigned b) { return __uint_as_float(b << 16); }
__device__ __forceinline__ float bflo(unsigned w) { return __uint_as_float(w << 16); }
__device__ __forceinline__ float bfhi(unsigned w) { return __uint_as_float(w & 0xffff0000u); }
typedef __bf16 bf16x2_t __attribute__((ext_vector_type(2)));
typedef float f32x2_t __attribute__((ext_vector_type(2)));
__device__ __forceinline__ unsigned cvt_pk_bf16(float lo, float hi) { const f32x2_t f = {lo, hi}; const bf16x2_t b = __builtin_convertvector(f, bf16x2_t); return __builtin_bit_cast(unsigned, b); }
__device__ __forceinline__ bf16_t f2bf(float f) { return (bf16_t)(cvt_pk_bf16(f, 0.f) & 0xffffu); }
__device__ __forceinline__ float sigmoidf_(float x) { return __builtin_amdgcn_rcpf(1.0f + __expf(-x)); }
__device__ __forceinline__ float siluf_(float x) { return x * sigmoidf_(x); }
__device__ __forceinline__ void unpack8(const u32x4 w, float (&f)[8]) {
    f[0] = bflo(w.x); f[1] = bfhi(w.x); f[2] = bflo(w.y); f[3] = bfhi(w.y); f[4] = bflo(w.z); f[5] = bfhi(w.z); f[6] = bflo(w.w); f[7] = bfhi(w.w);
}
__device__ __forceinline__ u32x4 pack8(const float (&f)[8]) {
    u32x4 w; w.x = cvt_pk_bf16(f[0], f[1]); w.y = cvt_pk_bf16(f[2], f[3]); w.z = cvt_pk_bf16(f[4], f[5]); w.w = cvt_pk_bf16(f[6], f[7]); return w;
}
__device__ __forceinline__ void st_wt16(void* p, u32x4 v) { asm volatile("global_store_dwordx4 %0, %1, off sc1\n\ts_nop 1" : : "v"(p), "v"(v) : "memory"); }
__device__ __forceinline__ void st_wt16_o256(void* p, u32x4 v) { asm volatile("global_store_dwordx4 %0, %1, off offset:256 sc1\n\ts_nop 1" : : "v"(p), "v"(v) : "memory"); }
typedef short s16x4 __attribute__((ext_vector_type(4)));
__device__ __forceinline__ u32x2 tr_read(LAS unsigned char* addr) { const s16x4 v = __builtin_amdgcn_ds_read_tr16_b64_v4i16((LAS s16x4*)addr); return __builtin_bit_cast(u32x2, v); }
__device__ __forceinline__ u32x4 ldg16(const void* base, unsigned off) { return *(const u32x4*)((const char*)base + off); }
__device__ __forceinline__ u32x2 ldg8(const void* base, unsigned off) { return *(const u32x2*)((const char*)base + off); }
__device__ __forceinline__ void stg8(void* base, unsigned off, u32x2 v) { *(u32x2*)((char*)base + off) = v; }
__device__ __forceinline__ float wave_sum(float v) {
    v += __shfl_xor(v, 32); v += __shfl_xor(v, 16); v += __shfl_xor(v, 8); v += __shfl_xor(v, 4); v += __shfl_xor(v, 2); v += __shfl_xor(v, 1); return v;
}

#define XB_TMO      128
#define XB_XCNT(j)  (256  + 64 * (j))
#define XB_XSUB(j)  (1280 + 64 * (j))
#define XB_XGEN(j)  (2304 + 64 * (j))
#define XB_TOP      3328
#define XB_TOPGEN   3392
#define XCD_BAR_WORDS 3456
#define XB_SPIN_CAP (1u << 18)
__device__ __forceinline__ unsigned xb_ld(unsigned* p)              { return __hip_atomic_load(p, __ATOMIC_RELAXED, __HIP_MEMORY_SCOPE_AGENT); }
__device__ __forceinline__ unsigned xb_add(unsigned* p, unsigned v) { return __hip_atomic_fetch_add(p, v, __ATOMIC_RELAXED, __HIP_MEMORY_SCOPE_AGENT); }
__device__ __forceinline__ unsigned xb_xcc_id() { return (unsigned)__builtin_amdgcn_s_getreg((3 << 11) | 20) & 0xFu; }
#define XB_SPIN(cond, bar) do { unsigned _sp = 0; while (cond) { __builtin_amdgcn_s_sleep(1); \
    if ((++_sp & 255u) == 0u) { if (xb_ld(&(bar)[XB_TMO])) break; if (_sp > XB_SPIN_CAP) { atomicAdd(&(bar)[XB_TMO], 1u); break; } } } } while (0)
struct XcdBarrier { unsigned* bar; unsigned x; volatile LAS unsigned* st; };
__device__ __forceinline__ XcdBarrier xcd_barrier_post(unsigned* bar, volatile LAS unsigned* st) {
    XcdBarrier b; b.bar = bar; b.x = xb_xcc_id(); b.st = st;
    if (threadIdx.x == 0) (void)xb_add(&bar[XB_XCNT(b.x)], 1u);
    return b;
}
__device__ __forceinline__ void xcd_barrier_complete(unsigned* bar, unsigned x, unsigned& nloc, unsigned& nx) {
    const unsigned G = gridDim.x * gridDim.y * gridDim.z;
    unsigned sum, cnt, mine, sp = 0u;
    for (;;) {
        sum = 0u; cnt = 0u; mine = 0u;
#pragma unroll
        for (unsigned j = 0; j < 16; ++j) { const unsigned c = xb_ld(&bar[XB_XCNT(j)]); sum += c; cnt += (c > 0u) ? 1u : 0u; mine = (j == x) ? c : mine; }
        if (sum == G) break;
        __builtin_amdgcn_s_sleep(1);
        if ((++sp & 255u) == 0u) { if (xb_ld(&bar[XB_TMO])) break; if (sp > XB_SPIN_CAP) { atomicAdd(&bar[XB_TMO], 1u); break; } }
    }
    nloc = mine > 0u ? mine : 1u; nx = cnt > 0u ? cnt : 1u;
}
__device__ __forceinline__ void xcd_barrier(const XcdBarrier& b) {
    asm volatile("s_waitcnt vmcnt(0)" ::: "memory");
    __syncthreads();
    if (threadIdx.x == 0) {
        unsigned* bar = b.bar;
        __builtin_amdgcn_s_waitcnt(0);
        unsigned nloc = b.st[0], nx = b.st[1];
        if (nloc == 0u) { xcd_barrier_complete(bar, b.x, nloc, nx); b.st[0] = nloc; b.st[1] = nx; }
        const unsigned old = xb_add(&bar[XB_XSUB(b.x)], 1u);
        const unsigned gen = old / nloc;
        if (old + 1u == (gen + 1u) * nloc) {
            __builtin_amdgcn_fence(__ATOMIC_RELEASE, "agent");
            asm volatile("s_waitcnt vmcnt(0)" ::: "memory");
            const unsigned og = xb_add(&bar[XB_TOP], 1u);
            const unsigned tg = og / nx;
            if (og + 1u == (tg + 1u) * nx) xb_add(&bar[XB_TOPGEN], 1u);
            else XB_SPIN(xb_ld(&bar[XB_TOPGEN]) == tg, bar);
            __builtin_amdgcn_fence(__ATOMIC_ACQUIRE, "agent");
            xb_add(&bar[XB_XGEN(b.x)], 1u);
            asm volatile("s_waitcnt vmcnt(0)" ::: "memory");
        } else {
            XB_SPIN(xb_ld(&bar[XB_XGEN(b.x)]) == gen, bar);
            __builtin_amdgcn_fence(__ATOMIC_ACQUIRE, "agent");
            asm volatile("s_waitcnt vmcnt(0)" ::: "memory");
        }
    }
    __syncthreads();
}

namespace pg8 {
constexpr int BM = 256, BK = 64, HALF = 128, HTB = HALF * BK * 2, STAGE_BYTES = 8 * HTB, NXCD = 8, WGM = 4;
__device__ __forceinline__ int lds_byte(int r, int c) { const int st = (r >> 4) * 2 + (c >> 5), rr = r & 15, cc = c & 31, ob = rr * 64 + cc * 2; return st * 1024 + (ob ^ (((ob >> 9) & 1) << 5)); }
__device__ __forceinline__ void stage_rc(int b, int& R, int& C) { const int st = b / 1024, sb = b % 1024, swz = sb ^ (((sb >> 9) & 1) << 5); R = (st >> 1) * 16 + swz / 64; C = (st & 1) * 32 + (swz % 64) / 2; }
__device__ __forceinline__ int perm32(int rho) { const int n = rho >> 4, i = rho & 15; return 8 * (i >> 2) + 4 * n + (i & 3); }
struct Unit { int pm, pn; };
struct Gemm { const bf16_t* A; const bf16_t* Bt; int M, N, K; };
struct StaticOrder {
    int nM, nN, nwg, G, c;
    __device__ void init(int M, int N, int G_, int c_) { nM = M / BM; nN = N / BM; nwg = nM * nN; G = G_; c = c_; }
    __device__ bool next(int i, Unit& u) const {
        const long L = (long)i * G + c; if (L >= nwg) return false;
        int wgid = (int)L; { const int q = nwg / NXCD, r = nwg % NXCD, xcd = wgid % NXCD, off = wgid / NXCD; wgid = (xcd < r ? xcd * (q + 1) : r * (q + 1) + (xcd - r) * q) + off; }
        const int nig = WGM * nN, gid = wgid / nig, fm = gid * WGM, gsz = (nM - fm) < WGM ? (nM - fm) : WGM;
        u.pm = fm + ((wgid % nig) % gsz); u.pn = (wgid % nig) / gsz; return true;
    }
};

template <class Epi, bool AFTER = false>
__device__ __forceinline__ void gemm_phase(LAS unsigned char* lds, const Gemm g, const StaticOrder& S, const Epi& E) {
    const int tid = threadIdx.x, wid = __builtin_amdgcn_readfirstlane(tid >> 6), lane = tid & 63, wr = wid >> 2, wc = wid & 3, fr = lane & 15, fq = lane >> 4;
    const int K = g.K, nt = K / BK;
    unsigned voffA[2], voffB[2];
#pragma unroll
    for (int i = 0; i < 2; ++i) { int R, C; stage_rc(tid * 16 + i * 8192, R, C); const int Rb = (R & ~31) + perm32(R & 31);
        voffA[i] = (unsigned)(R * K + C) * 2u; voffB[i] = (unsigned)(Rb * K + C) * 2u; }
    const size_t kstep = (size_t)(BK * 2);
    const size_t hstep = (size_t)HALF * K * 2;
    const size_t tstep = 2 * hstep;
    const unsigned ldsw = (unsigned)wid * 1024u;
    const int aoff = lds_byte(wr * 64 + fr, fq * 8), boff = lds_byte(wc * 32 + fr, fq * 8);
#define PG8_SA(b, h) (((b) * 2 + (h)) * HTB)
#define PG8_SB(b, h) ((4 + (b) * 2 + (h)) * HTB)
#define PG8_STAGE(bufoff, gbase, voff) do { _Pragma("unroll") for (int _i = 0; _i < 2; ++_i) \
        __builtin_amdgcn_global_load_lds((const unsigned*)((const char*)(gbase) + (voff)[_i]), (LAS unsigned*)(lds + (bufoff) + ldsw + _i * 8192), 16, 0, 0); } while (0)
#define PG8_LDA(dst, b, h) do { _Pragma("unroll") for (int m = 0; m < 4; ++m) _Pragma("unroll") for (int k = 0; k < 2; ++k) dst[m][k] = *(const LAS bf16x8*)(lds + PG8_SA(b, h) + aoff + m * 2048 + k * 1024); } while (0)
#define PG8_LDB(dst, b, h) do { _Pragma("unroll") for (int n = 0; n < 2; ++n) _Pragma("unroll") for (int k = 0; k < 2; ++k) dst[n][k] = *(const LAS bf16x8*)(lds + PG8_SB(b, h) + boff + n * 2048 + k * 1024); } while (0)
#define PG8_MMA(ai, bj, At, Bt) do { __builtin_amdgcn_s_setprio(1); _Pragma("unroll") for (int m = 0; m < 4; ++m) _Pragma("unroll") for (int n = 0; n < 2; ++n) _Pragma("unroll") for (int k = 0; k < 2; ++k) \
        acc[ai][bj][m][n] = __builtin_amdgcn_mfma_f32_16x16x32_bf16(Bt[n][k], At[m][k], acc[ai][bj][m][n], 0, 0, 0); __builtin_amdgcn_s_setprio(0); } while (0)
#define PG8_WAIT_V(n) asm volatile("s_waitcnt vmcnt(" #n ")" ::: "memory")
#define PG8_WAIT_L(n) asm volatile("s_waitcnt lgkmcnt(" #n ")" ::: "memory")
#define PG8_BAR __builtin_amdgcn_s_barrier()
#define PG8_SCHED __builtin_amdgcn_sched_barrier(0)
    Unit cur, nxt; int ui = 0;
    if (!S.next(0, cur)) return;
    f32x4 acc[2][2][4][2];
#pragma unroll
    for (int a = 0; a < 2; ++a)
#pragma unroll
        for (int b = 0; b < 2; ++b)
#pragma unroll
            for (int m = 0; m < 4; ++m)
#pragma unroll
                for (int n = 0; n < 2; ++n) acc[a][b][m][n] = (f32x4){0.f, 0.f, 0.f, 0.f};
    bf16x8 At[4][2], B0[2][2], B1[2][2];
    const char* cA = (const char*)g.A + (size_t)cur.pm * tstep; const char* cB = (const char*)g.Bt + (size_t)cur.pn * tstep;
    PG8_STAGE(PG8_SB(0, 0), cB, voffB); PG8_STAGE(PG8_SA(0, 0), cA, voffA); PG8_STAGE(PG8_SB(0, 1), cB + hstep, voffB); PG8_STAGE(PG8_SA(0, 1), cA + hstep, voffA);
    if (wr == 1) PG8_BAR;
    PG8_WAIT_V(4); PG8_BAR;
    PG8_STAGE(PG8_SB(1, 0), cB + kstep, voffB); PG8_STAGE(PG8_SA(1, 0), cA + kstep, voffA); PG8_STAGE(PG8_SB(1, 1), cB + hstep + kstep, voffB);
    PG8_WAIT_V(6); PG8_BAR;
    for (;;) {
        const bool has_next = S.next(ui + 1, nxt);
        const char* nA = has_next ? (const char*)g.A + (size_t)nxt.pm * tstep : cA; const char* nB = has_next ? (const char*)g.Bt + (size_t)nxt.pn * tstep : cB;
        for (int t = 0; t < nt; t += 2) {
            const bool last = (t == nt - 2);
            const char* a1 = cA + (size_t)(t + 1) * kstep;
            const char* a2 = last ? nA : cA + (size_t)(t + 2) * kstep; const char* b2 = last ? nB : cB + (size_t)(t + 2) * kstep;
            const char* a3 = a2 + kstep; const char* b3 = b2 + kstep;
            PG8_LDB(B0, 0, 0); PG8_SCHED; PG8_LDA(At, 0, 0); PG8_STAGE(PG8_SA(1, 1), a1 + hstep, voffA);
            PG8_WAIT_L(8); PG8_BAR; PG8_WAIT_L(0); PG8_MMA(0, 0, At, B0); PG8_BAR; PG8_SCHED;
            PG8_LDB(B1, 0, 1); PG8_STAGE(PG8_SB(0, 0), b2, voffB);
            PG8_BAR; PG8_WAIT_L(0); PG8_MMA(0, 1, At, B1); PG8_BAR;
            PG8_LDA(At, 0, 1); PG8_STAGE(PG8_SA(0, 0), a2, voffA);
            PG8_BAR; PG8_WAIT_L(0); PG8_MMA(1, 0, At, B0); PG8_BAR; PG8_SCHED;
            PG8_STAGE(PG8_SB(0, 1), b2 + hstep, voffB);
            PG8_WAIT_V(6); PG8_BAR; PG8_MMA(1, 1, At, B1); PG8_BAR;
            PG8_LDB(B0, 1, 0); PG8_SCHED; PG8_LDA(At, 1, 0); PG8_STAGE(PG8_SA(0, 1), a2 + hstep, voffA);
            PG8_WAIT_L(8); PG8_BAR; PG8_WAIT_L(0); PG8_MMA(0, 0, At, B0); PG8_BAR; PG8_SCHED;
            PG8_LDB(B1, 1, 1); PG8_STAGE(PG8_SB(1, 0), b3, voffB);
            PG8_BAR; PG8_WAIT_L(0); PG8_MMA(0, 1, At, B1); PG8_BAR;
            PG8_LDA(At, 1, 1); PG8_STAGE(PG8_SA(1, 0), a3, voffA);
            PG8_BAR; PG8_WAIT_L(0); PG8_MMA(1, 0, At, B0); PG8_BAR; PG8_SCHED;
            PG8_STAGE(PG8_SB(1, 1), b3 + hstep, voffB);
            PG8_WAIT_V(6); PG8_BAR; PG8_MMA(1, 1, At, B1); PG8_BAR;
        }
        if constexpr (!AFTER) E(acc, cur, wr, wc, fr, fq);
        if (!has_next) break;
#pragma unroll
        for (int a = 0; a < 2; ++a)
#pragma unroll
            for (int b = 0; b < 2; ++b)
#pragma unroll
                for (int m = 0; m < 4; ++m)
#pragma unroll
                    for (int n = 0; n < 2; ++n) acc[a][b][m][n] = (f32x4){0.f, 0.f, 0.f, 0.f};
        cur = nxt; cA = nA; cB = nB; ++ui;
    }
    PG8_WAIT_V(0);
    if (wr == 0) PG8_BAR;
    PG8_BAR;
    if constexpr (AFTER) E.fused(acc, cur, wr, wc, fr, fq, lds, wid, lane);
#undef PG8_SA
#undef PG8_SB
#undef PG8_STAGE
#undef PG8_LDA
#undef PG8_LDB
#undef PG8_MMA
#undef PG8_WAIT_V
#undef PG8_WAIT_L
#undef PG8_BAR
#undef PG8_SCHED
}
template <class EpiMid, class EpiEnd>
__device__ __forceinline__ void gemm_phase2(LAS unsigned char* lds, const Gemm g0, const Gemm g1, const StaticOrder& S, const EpiMid& Emid, const EpiEnd& Eend) {
    const int tid = threadIdx.x, wid = __builtin_amdgcn_readfirstlane(tid >> 6), lane = tid & 63, wr = wid >> 2, wc = wid & 3, fr = lane & 15, fq = lane >> 4;
    unsigned rA2[2], rB2[2], cb2[2];
#pragma unroll
    for (int i = 0; i < 2; ++i) { int R, C; stage_rc(tid * 16 + i * 8192, R, C); const int Rb = (R & ~31) + perm32(R & 31); rA2[i] = (unsigned)R * 2u; rB2[i] = (unsigned)Rb * 2u; cb2[i] = (unsigned)C * 2u; }
    const size_t kstep = (size_t)(BK * 2);
    const unsigned K0 = (unsigned)g0.K, K1 = (unsigned)g1.K;
    const size_t hstep0 = (size_t)HALF * g0.K * 2, hstep1 = (size_t)HALF * g1.K * 2;
    const unsigned ldsw = (unsigned)wid * 1024u;
    const int aoff = lds_byte(wr * 64 + fr, fq * 8), boff = lds_byte(wc * 32 + fr, fq * 8);
#define PG8_SA(b, h) (((b) * 2 + (h)) * HTB)
#define PG8_SB(b, h) ((4 + (b) * 2 + (h)) * HTB)
#define PG8_STAGE2(bufoff, gbase, r2, Ksel) do { \
        __builtin_amdgcn_global_load_lds((const unsigned*)((const char*)(gbase) + ((r2)[0] * (Ksel) + cb2[0])), (LAS unsigned*)(lds + (bufoff) + ldsw), 16, 0, 0); \
        __builtin_amdgcn_global_load_lds((const unsigned*)((const char*)(gbase) + ((r2)[1] * (Ksel) + cb2[1])), (LAS unsigned*)(lds + (bufoff) + ldsw + 8192), 16, 0, 0); } while (0)
#define PG8_LDA(dst, b, h) do { _Pragma("unroll") for (int m = 0; m < 4; ++m) _Pragma("unroll") for (int k = 0; k < 2; ++k) dst[m][k] = *(const LAS bf16x8*)(lds + PG8_SA(b, h) + aoff + m * 2048 + k * 1024); } while (0)
#define PG8_LDB(dst, b, h) do { _Pragma("unroll") for (int n = 0; n < 2; ++n) _Pragma("unroll") for (int k = 0; k < 2; ++k) dst[n][k] = *(const LAS bf16x8*)(lds + PG8_SB(b, h) + boff + n * 2048 + k * 1024); } while (0)
#define PG8_MMA(ai, bj, At, Bt) do { __builtin_amdgcn_s_setprio(1); _Pragma("unroll") for (int m = 0; m < 4; ++m) _Pragma("unroll") for (int n = 0; n < 2; ++n) _Pragma("unroll") for (int k = 0; k < 2; ++k) \
        acc[ai][bj][m][n] = __builtin_amdgcn_mfma_f32_16x16x32_bf16(Bt[n][k], At[m][k], acc[ai][bj][m][n], 0, 0, 0); __builtin_amdgcn_s_setprio(0); } while (0)
#define PG8_WAIT_V(n) asm volatile("s_waitcnt vmcnt(" #n ")" ::: "memory")
#define PG8_WAIT_L(n) asm volatile("s_waitcnt lgkmcnt(" #n ")" ::: "memory")
#define PG8_BAR __builtin_amdgcn_s_barrier()
#define PG8_SCHED __builtin_amdgcn_sched_barrier(0)
    Unit cur, nxt; int ui = 0;
    if (!S.next(0, cur)) return;
    f32x4 acc[2][2][4][2];
#pragma unroll
    for (int a = 0; a < 2; ++a)
#pragma unroll
        for (int b = 0; b < 2; ++b)
#pragma unroll
            for (int m = 0; m < 4; ++m)
#pragma unroll
                for (int n = 0; n < 2; ++n) acc[a][b][m][n] = (f32x4){0.f, 0.f, 0.f, 0.f};
    bf16x8 At[4][2], B0[2][2], B1[2][2];
    const char* cA = (const char*)g0.A + (size_t)cur.pm * 2 * hstep0; const char* cB = (const char*)g0.Bt + (size_t)cur.pn * 2 * hstep0;
    PG8_STAGE2(PG8_SB(0, 0), cB, rB2, K0); PG8_STAGE2(PG8_SA(0, 0), cA, rA2, K0);
    PG8_STAGE2(PG8_SB(0, 1), cB + hstep0, rB2, K0); PG8_STAGE2(PG8_SA(0, 1), cA + hstep0, rA2, K0);
    if (wr == 1) PG8_BAR;
    PG8_WAIT_V(4); PG8_BAR;
    PG8_STAGE2(PG8_SB(1, 0), cB + kstep, rB2, K0); PG8_STAGE2(PG8_SA(1, 0), cA + kstep, rA2, K0); PG8_STAGE2(PG8_SB(1, 1), cB + hstep0 + kstep, rB2, K0);
    PG8_WAIT_V(6); PG8_BAR;
    for (;;) {
        const bool has_next = S.next(ui + 1, nxt);
#pragma unroll 1
        for (int seg = 0; seg < 2; ++seg) {
            const int nt = (seg == 0 ? g0.K : g1.K) / BK;
            const size_t hs = seg == 0 ? hstep0 : hstep1, hsn = seg == 0 ? hstep1 : hstep0;
            const unsigned Kc = seg == 0 ? K0 : K1, Kn = seg == 0 ? K1 : K0;
            const Unit& nu = (seg == 0) ? cur : (has_next ? nxt : cur);
            const char* nA = (seg == 0) ? (const char*)g1.A + (size_t)nu.pm * 2 * hstep1 : (const char*)g0.A + (size_t)nu.pm * 2 * hstep0;
            const char* nB = (seg == 0) ? (const char*)g1.Bt + (size_t)nu.pn * 2 * hstep1 : (const char*)g0.Bt + (size_t)nu.pn * 2 * hstep0;
            for (int t = 0; t < nt; t += 2) {
                const bool last = (t == nt - 2);
                const char* a1 = cA + (size_t)(t + 1) * kstep;
                const char* a2 = last ? nA : cA + (size_t)(t + 2) * kstep; const char* b2 = last ? nB : cB + (size_t)(t + 2) * kstep;
                const char* a3 = a2 + kstep; const char* b3 = b2 + kstep;
                const size_t h2 = last ? hsn : hs;
                const unsigned K2 = last ? Kn : Kc;
                PG8_LDB(B0, 0, 0); PG8_SCHED; PG8_LDA(At, 0, 0); PG8_STAGE2(PG8_SA(1, 1), a1 + hs, rA2, Kc);
                PG8_WAIT_L(8); PG8_BAR; PG8_WAIT_L(0); PG8_MMA(0, 0, At, B0); PG8_BAR; PG8_SCHED;
                PG8_LDB(B1, 0, 1); PG8_STAGE2(PG8_SB(0, 0), b2, rB2, K2);
                PG8_BAR; PG8_WAIT_L(0); PG8_MMA(0, 1, At, B1); PG8_BAR;
                PG8_LDA(At, 0, 1); PG8_STAGE2(PG8_SA(0, 0), a2, rA2, K2);
                PG8_BAR; PG8_WAIT_L(0); PG8_MMA(1, 0, At, B0); PG8_BAR; PG8_SCHED;
                PG8_STAGE2(PG8_SB(0, 1), b2 + h2, rB2, K2);
                PG8_WAIT_V(6); PG8_BAR; PG8_MMA(1, 1, At, B1); PG8_BAR;
                PG8_LDB(B0, 1, 0); PG8_SCHED; PG8_LDA(At, 1, 0); PG8_STAGE2(PG8_SA(0, 1), a2 + h2, rA2, K2);
                PG8_WAIT_L(8); PG8_BAR; PG8_WAIT_L(0); PG8_MMA(0, 0, At, B0); PG8_BAR; PG8_SCHED;
                PG8_LDB(B1, 1, 1); PG8_STAGE2(PG8_SB(1, 0), b3, rB2, K2);
                PG8_BAR; PG8_WAIT_L(0); PG8_MMA(0, 1, At, B1); PG8_BAR;
                PG8_LDA(At, 1, 1); PG8_STAGE2(PG8_SA(1, 0), a3, rA2, K2);
                PG8_BAR; PG8_WAIT_L(0); PG8_MMA(1, 0, At, B0); PG8_BAR; PG8_SCHED;
                PG8_STAGE2(PG8_SB(1, 1), b3 + h2, rB2, K2);
                PG8_WAIT_V(6); PG8_BAR; PG8_MMA(1, 1, At, B1); PG8_BAR;
            }
            if (seg == 0) Emid(acc, cur, wr, wc, fr, fq); else Eend(acc, cur, wr, wc, fr, fq);
            cA = nA; cB = nB;
        }
        if (!has_next) break;
#pragma unroll
        for (int a = 0; a < 2; ++a)
#pragma unroll
            for (int b = 0; b < 2; ++b)
#pragma unroll
                for (int m = 0; m < 4; ++m)
#pragma unroll
                    for (int n = 0; n < 2; ++n) acc[a][b][m][n] = (f32x4){0.f, 0.f, 0.f, 0.f};
        cur = nxt; ++ui;
    }
    PG8_WAIT_V(0);
    if (wr == 0) PG8_BAR;
    PG8_BAR;
#undef PG8_SA
#undef PG8_SB
#undef PG8_STAGE2
#undef PG8_LDA
#undef PG8_LDB
#undef PG8_MMA
#undef PG8_WAIT_V
#undef PG8_WAIT_L
#undef PG8_BAR
#undef PG8_SCHED
}
}

#define EPI_LOOP_BEGIN \
    const int row0 = u.pm * 256 + wr * 64 + fr; \
    _Pragma("unroll") for (int ai = 0; ai < 2; ++ai) _Pragma("unroll") for (int m = 0; m < 4; ++m) { const int row = row0 + ai * 128 + m * 16; \
    _Pragma("unroll") for (int bj = 0; bj < 2; ++bj) { const f32x4 v0 = acc[ai][bj][m][0], v1 = acc[ai][bj][m][1];
#define EPI_LOOP_END } }

struct EpiStoreBf16 {
    bf16_t* O1; int ld1; int split_pn; bf16_t* O2; int ld2;
    __device__ __forceinline__ void operator()(const f32x4 (&acc)[2][2][4][2], const pg8::Unit& u, int wr, int wc, int fr, int fq) const {
        bf16_t* base; int ld, colt;
        if (u.pn < split_pn) { base = O1; ld = ld1; colt = u.pn * 256; } else { base = O2; ld = ld2; colt = (u.pn - split_pn) * 256; }
        const int col0 = colt + wc * 32 + 8 * fq; const int row0 = u.pm * 256 + wr * 64 + fr;
#pragma unroll
        for (int ai = 0; ai < 2; ++ai)
#pragma unroll
            for (int m = 0; m < 4; ++m) {
                bf16_t* rp = base + (size_t)(row0 + ai * 128 + m * 16) * ld + col0;
                u32x4 w0, w1;
                w0.x = cvt_pk_bf16(acc[ai][0][m][0][0], acc[ai][0][m][0][1]); w0.y = cvt_pk_bf16(acc[ai][0][m][0][2], acc[ai][0][m][0][3]);
                w0.z = cvt_pk_bf16(acc[ai][0][m][1][0], acc[ai][0][m][1][1]); w0.w = cvt_pk_bf16(acc[ai][0][m][1][2], acc[ai][0][m][1][3]);
                w1.x = cvt_pk_bf16(acc[ai][1][m][0][0], acc[ai][1][m][0][1]); w1.y = cvt_pk_bf16(acc[ai][1][m][0][2], acc[ai][1][m][0][3]);
                w1.z = cvt_pk_bf16(acc[ai][1][m][1][0], acc[ai][1][m][1][1]); w1.w = cvt_pk_bf16(acc[ai][1][m][1][2], acc[ai][1][m][1][3]);
                st_wt16(rp, w0); st_wt16_o256(rp, w1);
            }
    }
};
struct EpiProjB {
    bf16_t* QZ; bf16_t* KA; bf16_t* VA; bf16_t* Gm;
    __device__ __forceinline__ void operator()(const f32x4 (&acc)[2][2][4][2], const pg8::Unit& u, int wr, int wc, int fr, int fq) const {
        const int pn = u.pn; const int row0 = u.pm * 256 + wr * 64 + fr; const int cl = wc * 32 + 8 * fq;
#pragma unroll
        for (int ai = 0; ai < 2; ++ai)
#pragma unroll
            for (int m = 0; m < 4; ++m) {
                const int row = row0 + ai * 128 + m * 16;
                u32x4 w0, w1;
                w0.x = cvt_pk_bf16(acc[ai][0][m][0][0], acc[ai][0][m][0][1]); w0.y = cvt_pk_bf16(acc[ai][0][m][0][2], acc[ai][0][m][0][3]);
                w0.z = cvt_pk_bf16(acc[ai][0][m][1][0], acc[ai][0][m][1][1]); w0.w = cvt_pk_bf16(acc[ai][0][m][1][2], acc[ai][0][m][1][3]);
                w1.x = cvt_pk_bf16(acc[ai][1][m][0][0], acc[ai][1][m][0][1]); w1.y = cvt_pk_bf16(acc[ai][1][m][0][2], acc[ai][1][m][0][3]);
                w1.z = cvt_pk_bf16(acc[ai][1][m][1][0], acc[ai][1][m][1][1]); w1.w = cvt_pk_bf16(acc[ai][1][m][1][2], acc[ai][1][m][1][3]);
                if (pn < 6) { bf16_t* rp = QZ + (size_t)row * QZ_LD + pn * 256 + cl; st_wt16(rp, w0); st_wt16_o256(rp, w1); }
                else if (pn < 18) {
                    bf16_t* base = (pn < 12) ? KA : VA; const int c = (pn < 12 ? pn - 6 : pn - 12) * 256 + cl;
                    const int b = row >> 11, pos = row & 2047;
#pragma unroll
                    for (int bj = 0; bj < 2; ++bj) {
                        const int cc = c + bj * 128; const int g = cc >> 9, h = (cc >> 7) & 3, e = cc & 127; const int lg = 2 * g;
                        const int rr = pos & ((1 << lg) - 1), j = pos >> lg;
                        const size_t off = (size_t)g * ((size_t)T_TOK * 512) + ((size_t)((((b * 4 + h) << lg) + rr) * (2048 >> lg) + j)) * 128 + e;
                        st_wt16(base + off, bj == 0 ? w0 : w1);
                    }
                }
                else if (pn < 20) { bf16_t* rp = QZ + (size_t)row * QZ_LD + 1536 + (pn - 18) * 256 + cl; st_wt16(rp, w0); st_wt16_o256(rp, w1); }
                else { bf16_t* rp = Gm + (size_t)row * 2048 + (pn - 20) * 256 + cl; st_wt16(rp, w0); st_wt16_o256(rp, w1); }
            }
    }
};
struct EpiGateF32 {
    const bf16_t* Gt; float* TMP;
    __device__ __forceinline__ void operator()(const f32x4 (&acc)[2][2][4][2], const pg8::Unit& u, int wr, int wc, int fr, int fq) const {
        const int col0 = u.pn * 256 + wc * 32 + 8 * fq; const int row0 = u.pm * 256 + wr * 64 + fr;
#pragma unroll
        for (int ai = 0; ai < 2; ++ai) {
            u32x4 gw[4][2];
#pragma unroll
            for (int m = 0; m < 4; ++m)
#pragma unroll
                for (int bj = 0; bj < 2; ++bj) gw[m][bj] = *(const u32x4*)(Gt + (size_t)(row0 + ai * 128 + m * 16) * 2048 + col0 + bj * 128);
#pragma unroll
            for (int m = 0; m < 4; ++m)
#pragma unroll
                for (int bj = 0; bj < 2; ++bj) {
                    const f32x4 v0 = acc[ai][bj][m][0], v1 = acc[ai][bj][m][1]; float gf[8]; unpack8(gw[m][bj], gf);
                    f32x4 o0, o1;
                    o0[0] = sigmoidf_(gf[0]) * v0[0]; o0[1] = sigmoidf_(gf[1]) * v0[1]; o0[2] = sigmoidf_(gf[2]) * v0[2]; o0[3] = sigmoidf_(gf[3]) * v0[3];
                    o1[0] = sigmoidf_(gf[4]) * v1[0]; o1[1] = sigmoidf_(gf[5]) * v1[1]; o1[2] = sigmoidf_(gf[6]) * v1[2]; o1[3] = sigmoidf_(gf[7]) * v1[3];
                    float* tp = TMP + (size_t)(row0 + ai * 128 + m * 16) * 1024 + col0 + bj * 128; *(f32x4*)tp = o0; *(f32x4*)(tp + 4) = o1;
                }
        }
    }
};
struct EpiMerge {
    const bf16_t* Gt; const float* TMP; bf16_t* MG;
    __device__ __forceinline__ void operator()(const f32x4 (&acc)[2][2][4][2], const pg8::Unit& u, int wr, int wc, int fr, int fq) const {
        const int col0 = u.pn * 256 + wc * 32 + 8 * fq; const int row0 = u.pm * 256 + wr * 64 + fr;
#pragma unroll
        for (int ai = 0; ai < 2; ++ai)
#pragma unroll
            for (int mp = 0; mp < 2; ++mp) {
                u32x4 gw[2][2]; f32x4 t0[2][2], t1[2][2];
#pragma unroll
                for (int mm = 0; mm < 2; ++mm)
#pragma unroll
                    for (int bj = 0; bj < 2; ++bj) {
                        const size_t row = (size_t)(row0 + ai * 128 + (2 * mp + mm) * 16); const int col = col0 + bj * 128;
                        gw[mm][bj] = *(const u32x4*)(Gt + row * 2048 + 1024 + col);
                        const float* tp = TMP + row * 1024 + col; t0[mm][bj] = *(const f32x4*)tp; t1[mm][bj] = *(const f32x4*)(tp + 4);
                    }
#pragma unroll
                for (int mm = 0; mm < 2; ++mm)
#pragma unroll
                    for (int bj = 0; bj < 2; ++bj) {
                        const int m = 2 * mp + mm; const f32x4 v0 = acc[ai][bj][m][0], v1 = acc[ai][bj][m][1]; float gf[8]; unpack8(gw[mm][bj], gf);
                        float o[8];
                        o[0] = t0[mm][bj][0] + sigmoidf_(gf[0]) * v0[0]; o[1] = t0[mm][bj][1] + sigmoidf_(gf[1]) * v0[1]; o[2] = t0[mm][bj][2] + sigmoidf_(gf[2]) * v0[2]; o[3] = t0[mm][bj][3] + sigmoidf_(gf[3]) * v0[3];
                        o[4] = t1[mm][bj][0] + sigmoidf_(gf[4]) * v1[0]; o[5] = t1[mm][bj][1] + sigmoidf_(gf[5]) * v1[1]; o[6] = t1[mm][bj][2] + sigmoidf_(gf[6]) * v1[2]; o[7] = t1[mm][bj][3] + sigmoidf_(gf[7]) * v1[3];
                        *(u32x4*)(MG + (size_t)(row0 + ai * 128 + m * 16) * 1024 + col0 + bj * 128) = pack8(o);
                    }
            }
    }
};
struct EpiRatio {
    const bf16_t* Gt;
    __device__ __forceinline__ void operator()(f32x4 (&acc)[2][2][4][2], const pg8::Unit& u, int wr, int wc, int fr, int fq) const {
        unsigned goff = ((unsigned)(u.pm * 256 + wr * 64 + fr) * 2048u + (unsigned)(u.pn * 256 + wc * 32 + 8 * fq)) * 2u;
        asm volatile("" : "+v"(goff));
#pragma unroll
        for (int ai = 0; ai < 2; ++ai)
#pragma unroll
            for (int mp = 0; mp < 2; ++mp) {
                u32x4 gm[2][2], ga[2][2];
#pragma unroll
                for (int mm = 0; mm < 2; ++mm) {
                    const unsigned ro = goff + (unsigned)(ai * 128 + (2 * mp + mm) * 16) * 4096u;
#pragma unroll
                    for (int bj = 0; bj < 2; ++bj) { gm[mm][bj] = __builtin_nontemporal_load((const u32x4*)((const char*)Gt + (ro + 256u * bj))); ga[mm][bj] = *(const u32x4*)((const char*)Gt + (ro + 2048u + 256u * bj)); }
                }
#pragma unroll
                for (int mm = 0; mm < 2; ++mm)
#pragma unroll
                    for (int bj = 0; bj < 2; ++bj) {
                        const int m = 2 * mp + mm; float fm[8], fa[8]; unpack8(gm[mm][bj], fm); unpack8(ga[mm][bj], fa);
#pragma unroll
                        for (int e = 0; e < 8; ++e) {
                            const float ratio = (1.0f + __expf(-fa[e])) * __builtin_amdgcn_rcpf(1.0f + __expf(-fm[e]));
                            acc[ai][bj][m][e >> 2][e & 3] *= ratio;
                        }
                    }
                asm volatile("" ::: "memory");
            }
    }
};
struct EpiMerge2 {
    const bf16_t* Gt; bf16_t* MG;
    __device__ __forceinline__ void operator()(f32x4 (&acc)[2][2][4][2], const pg8::Unit& u, int wr, int wc, int fr, int fq) const {
        const unsigned row0 = (unsigned)(u.pm * 256 + wr * 64 + fr), col0 = (unsigned)(u.pn * 256 + wc * 32 + 8 * fq);
        unsigned goff = (row0 * 2048u + 1024u + col0) * 2u, moff = (row0 * 1024u + col0) * 2u;
        asm volatile("" : "+v"(goff), "+v"(moff));
#pragma unroll
        for (int ai = 0; ai < 2; ++ai) {
            u32x4 ga[4][2];
#pragma unroll
            for (int m = 0; m < 4; ++m)
#pragma unroll
                for (int bj = 0; bj < 2; ++bj) ga[m][bj] = __builtin_nontemporal_load((const u32x4*)((const char*)Gt + (goff + (unsigned)(ai * 128 + m * 16) * 4096u + 256u * bj)));
#pragma unroll
            for (int m = 0; m < 4; ++m) {
                const unsigned rm = moff + (unsigned)(ai * 128 + m * 16) * 2048u;
#pragma unroll
                for (int bj = 0; bj < 2; ++bj) {
                    float fa[8], o[8]; unpack8(ga[m][bj], fa);
#pragma unroll
                    for (int e = 0; e < 8; ++e) o[e] = sigmoidf_(fa[e]) * acc[ai][bj][m][e >> 2][e & 3];
                    *(u32x4*)((char*)MG + (rm + 256u * bj)) = pack8(o);
                }
            }
            asm volatile("" ::: "memory");
        }
    }
};
struct EpiF32 {
    float* Y;
    __device__ __forceinline__ void operator()(const f32x4 (&acc)[2][2][4][2], const pg8::Unit& u, int wr, int wc, int fr, int fq) const {
        const int col0 = u.pn * 256 + wc * 32 + 8 * fq;
        EPI_LOOP_BEGIN
            float* yp = Y + (size_t)row * 1024 + col0 + bj * 128; *(f32x4*)yp = v0; *(f32x4*)(yp + 4) = v1;
        EPI_LOOP_END
    }
};

struct EpiRmsRes {
    const float* x; const float* post_w; float* out; float* X; unsigned* cnt;
    __device__ __forceinline__ void fused(f32x4 (&acc)[2][2][4][2], const pg8::Unit& u, int wr, int wc, int fr, int fq, LAS unsigned char* lds, int wid, int lane) const {
        LAS float* P = (LAS float*)lds;
        LAS float* S = (LAS float*)(lds + 4096);
        const int tid = threadIdx.x;
        const int col0 = u.pn * 256 + wc * 32 + 8 * fq;
        const size_t off0 = (size_t)(u.pm * 256 + wr * 64 + fr) * 1024 + col0;
        f32x4 xv[4][2][2];
#pragma unroll
        for (int m = 0; m < 4; ++m)
#pragma unroll
            for (int bj = 0; bj < 2; ++bj) { xv[m][bj][0] = __builtin_nontemporal_load((const f32x4*)(x + off0 + (size_t)(m * 16) * 1024 + bj * 128)); xv[m][bj][1] = __builtin_nontemporal_load((const f32x4*)(x + off0 + (size_t)(m * 16) * 1024 + bj * 128 + 4)); }
#pragma unroll
        for (int ai = 0; ai < 2; ++ai)
#pragma unroll
            for (int m = 0; m < 4; ++m) {
                float sq = 0.f;
#pragma unroll
                for (int bj = 0; bj < 2; ++bj)
#pragma unroll
                    for (int n = 0; n < 2; ++n) { const f32x4 v = acc[ai][bj][m][n]; sq += (v[0] * v[0] + v[1] * v[1]) + (v[2] * v[2] + v[3] * v[3]); }
                sq += __shfl_xor(sq, 16); sq += __shfl_xor(sq, 32);
                if (fq == 0) P[(ai * 128 + wr * 64 + m * 16 + fr) * 4 + wc] = sq;
            }
        __syncthreads();
        if (tid < 256) {
            const f32x4 pv = *(const LAS f32x4*)(P + tid * 4);
            __hip_atomic_store(X + ((size_t)u.pm * 256 + tid) * 4 + u.pn, (pv[0] + pv[1]) + (pv[2] + pv[3]), __ATOMIC_RELAXED, __HIP_MEMORY_SCOPE_AGENT);
        }
        asm volatile("s_waitcnt vmcnt(0)" ::: "memory");
        __syncthreads();
        if (tid == 0) {
            __hip_atomic_fetch_add(cnt + u.pm, 1u, __ATOMIC_RELAXED, __HIP_MEMORY_SCOPE_AGENT);
            for (unsigned sp = 0; sp < (1u << 22); ++sp) { if (__hip_atomic_load(cnt + u.pm, __ATOMIC_RELAXED, __HIP_MEMORY_SCOPE_AGENT) >= 4u) break; __builtin_amdgcn_s_sleep(1); }
            __builtin_amdgcn_fence(__ATOMIC_ACQUIRE, "agent");
            asm volatile("s_waitcnt vmcnt(0)" ::: "memory");
        }
        __syncthreads();
        if (tid < 256) {
            const float* xp = X + ((size_t)u.pm * 256 + tid) * 4;
            const float t = (__hip_atomic_load(xp, __ATOMIC_RELAXED, __HIP_MEMORY_SCOPE_AGENT) + __hip_atomic_load(xp + 1, __ATOMIC_RELAXED, __HIP_MEMORY_SCOPE_AGENT))
                          + (__hip_atomic_load(xp + 2, __ATOMIC_RELAXED, __HIP_MEMORY_SCOPE_AGENT) + __hip_atomic_load(xp + 3, __ATOMIC_RELAXED, __HIP_MEMORY_SCOPE_AGENT));
            S[tid] = rsqrtf(t * (1.0f / 1024.0f) + EPS);
        }
        __syncthreads();
        f32x4 pw[2][2];
#pragma unroll
        for (int bj = 0; bj < 2; ++bj) { pw[bj][0] = *(const f32x4*)(post_w + col0 + bj * 128); pw[bj][1] = *(const f32x4*)(post_w + col0 + bj * 128 + 4); }
#pragma unroll
        for (int ai = 0; ai < 2; ++ai) {
            if (ai == 1) {
#pragma unroll
                for (int m = 0; m < 4; ++m)
#pragma unroll
                    for (int bj = 0; bj < 2; ++bj) { xv[m][bj][0] = __builtin_nontemporal_load((const f32x4*)(x + off0 + (size_t)(128 + m * 16) * 1024 + bj * 128)); xv[m][bj][1] = __builtin_nontemporal_load((const f32x4*)(x + off0 + (size_t)(128 + m * 16) * 1024 + bj * 128 + 4)); }
            }
#pragma unroll
            for (int m = 0; m < 4; ++m) {
                const int lr = ai * 128 + wr * 64 + m * 16 + fr; const float rs = S[lr];
                const size_t off = off0 + (size_t)(ai * 128 + m * 16) * 1024;
#pragma unroll
                for (int bj = 0; bj < 2; ++bj) {
                    *(f32x4*)(out + off + bj * 128) = xv[m][bj][0] + acc[ai][bj][m][0] * rs * pw[bj][0];
                    *(f32x4*)(out + off + bj * 128 + 4) = xv[m][bj][1] + acc[ai][bj][m][1] * rs * pw[bj][1];
                }
            }
            asm volatile("" ::: "memory");
        }
    }
};

__device__ __forceinline__ void p0_prep(const Params& p, LAS unsigned char* lds) {
    const int tid = threadIdx.x, G = gridDim.x, bid = blockIdx.x, lane = tid & 63, wid = tid >> 6;
    unsigned char* ws = p.ws;
    LAS float* tile = (LAS float*)lds;
    LAS float* WG = (LAS float*)(lds + 32768);
    for (int i = tid; i < 2048; i += 512) { const int k = i >> 1, hf = i & 1; *(LAS f32x4*)(WG + k * 8 + hf * 4) = *(const f32x4*)(p.w_in + (size_t)k * INW + 5120 + hf * 4); }
    LAS float* strip = (LAS float*)(lds + 65536);
    for (int tI = bid; tI < 928; tI += G) {
        const float* src; bf16_t* dst; int ldn, Kdim, ns, kt, srccol;
        int u = tI;
        if (u < 768) { ns = u >> 4; kt = u & 15; src = p.w_in; ldn = INW; Kdim = 1024; dst = (bf16_t*)(ws + WS_WIN); srccol = ns * 256 + (ns >= 20 ? 8 : 0); }
        else if (u < 832) { u -= 768; ns = u >> 4; kt = u & 15; src = p.w_pm; ldn = 1024; Kdim = 1024; dst = (bf16_t*)(ws + WS_WPM); srccol = ns * 256; }
        else if (u < 864) { u -= 832; ns = u >> 3; kt = u & 7; src = p.w_pa; ldn = 1024; Kdim = 512; dst = (bf16_t*)(ws + WS_WPA); srccol = ns * 256; }
        else { u -= 864; ns = u >> 4; kt = u & 15; src = p.w_out; ldn = 1024; Kdim = 1024; dst = (bf16_t*)(ws + WS_WOUT); srccol = ns * 256; }
        float4 v[8];
#pragma unroll
        for (int i = 0; i < 8; ++i) { const int idx = tid + 512 * i; const int k = idx >> 6, n4 = idx & 63; const f32x4 t = __builtin_nontemporal_load((const f32x4*)(src + (size_t)(kt * 64 + k) * ldn + srccol + 4 * n4)); v[i] = make_float4(t[0], t[1], t[2], t[3]); }
#pragma unroll
        for (int i = 0; i < 8; ++i) { const int idx = tid + 512 * i; const int k = idx >> 6, n4 = idx & 63;
            strip[k * 257 + 4 * n4 + 0] = v[i].x; strip[k * 257 + 4 * n4 + 1] = v[i].y; strip[k * 257 + 4 * n4 + 2] = v[i].z; strip[k * 257 + 4 * n4 + 3] = v[i].w; }
        __syncthreads();
#pragma unroll
        for (int j = 0; j < 4; ++j) { const int piece = tid + 512 * j; const int n = piece >> 3, kv = piece & 7; float f[8];
#pragma unroll
            for (int e = 0; e < 8; ++e) f[e] = strip[(kv * 8 + e) * 257 + n];
            *(u32x4*)(dst + (size_t)(ns * 256 + n) * Kdim + kt * 64 + kv * 8) = pack8(f); }
        __syncthreads();
    }
    __syncthreads();
    bf16_t* H = (bf16_t*)((unsigned char*)p.out + OUT_H);
    float* GATES = (float*)(ws + WS_GATES);
    const float bias_l = p.b_if[((lane >> 5) & 1) * 4 + ((lane >> 4) & 1) * 2 + ((lane >> 3) & 1)];
    for (int row0 = (bid * 8 + wid) * 2; row0 < T_TOK; row0 += G * 16) {
        float4 v[2][4];
#pragma unroll
        for (int rr = 0; rr < 2; ++rr)
#pragma unroll
            for (int i = 0; i < 4; ++i) { const f32x4 t = __builtin_nontemporal_load((const f32x4*)(p.x + (size_t)(row0 + rr) * 1024) + (i * 64 + lane)); v[rr][i] = make_float4(t[0], t[1], t[2], t[3]); }
#pragma unroll
        for (int rr = 0; rr < 2; ++rr) {
            const int row = row0 + rr;
            float ss = 0.f;
#pragma unroll
            for (int i = 0; i < 4; ++i) ss += v[rr][i].x * v[rr][i].x + v[rr][i].y * v[rr][i].y + v[rr][i].z * v[rr][i].z + v[rr][i].w * v[rr][i].w;
            ss = wave_sum(ss);
            const float rstd = rsqrtf(ss * (1.0f / 1024.0f) + EPS);
            float g[8];
#pragma unroll
            for (int j = 0; j < 8; ++j) g[j] = 0.f;
#pragma unroll
            for (int i = 0; i < 4; ++i) {
                const float4 pw = ((const float4*)p.pre_w)[i * 64 + lane];
                float hv[4] = {v[rr][i].x * rstd * pw.x, v[rr][i].y * rstd * pw.y, v[rr][i].z * rstd * pw.z, v[rr][i].w * rstd * pw.w};
                u32x2 w; w.x = cvt_pk_bf16(hv[0], hv[1]); w.y = cvt_pk_bf16(hv[2], hv[3]);
                *(u32x2*)(H + (size_t)row * 1024 + (i * 64 + lane) * 4) = w;
#pragma unroll
                for (int e = 0; e < 4; ++e) {
                    const int k = (i * 64 + lane) * 4 + e;
                    const f32x4 wa = *(const LAS f32x4*)(WG + k * 8), wb = *(const LAS f32x4*)(WG + k * 8 + 4);
                    g[0] += hv[e] * wa[0]; g[1] += hv[e] * wa[1]; g[2] += hv[e] * wa[2]; g[3] += hv[e] * wa[3];
                    g[4] += hv[e] * wb[0]; g[5] += hv[e] * wb[1]; g[6] += hv[e] * wb[2]; g[7] += hv[e] * wb[3];
                }
            }
            const bool h32 = (lane & 32) != 0, h16 = (lane & 16) != 0, h8 = (lane & 8) != 0;
            float t4[4], t2[2];
#pragma unroll
            for (int j = 0; j < 4; ++j) { const float send = h32 ? g[j] : g[j + 4], keep = h32 ? g[j + 4] : g[j]; t4[j] = keep + __shfl_xor(send, 32); }
#pragma unroll
            for (int j = 0; j < 2; ++j) { const float send = h16 ? t4[j] : t4[j + 2], keep = h16 ? t4[j + 2] : t4[j]; t2[j] = keep + __shfl_xor(send, 16); }
            float gt; { const float send = h8 ? t2[0] : t2[1], keep = h8 ? t2[1] : t2[0]; gt = keep + __shfl_xor(send, 8); }
            gt += __shfl_xor(gt, 4); gt += __shfl_xor(gt, 2); gt += __shfl_xor(gt, 1);
            if ((lane & 7) == 0) {
                const int j = (h32 ? 4 : 0) + (h16 ? 2 : 0) + (h8 ? 1 : 0);
                const float gv = gt + bias_l;
                GATES[(size_t)row * 8 + j] = (j < 4) ? gv : (fminf(gv, 0.f) - log1pf(expf(-fabsf(gv))));
            }
        }
    }
    float* RC = (float*)(ws + WS_ROPE); float* RS = RC + 2048 * 16;
    for (int idx = bid * 512 + tid; idx < 2048 * 16; idx += G * 512) {
        const int pos = idx >> 4, i = idx & 15;
        const float inv = powf(500000.0f, -(float)(2 * i) / 32.0f);
        const float ang = (float)pos * inv;
        RC[idx] = cosf(ang); RS[idx] = sinf(ang);
    }
}

constexpr int ML_KB = 0, ML_VT = 67584, ML_WVT = 81920, ML_CT = 96256, ML_G = 124928;
constexpr int KB_STRIDE = 528, VR_STRIDE = 112;

__device__ __forceinline__ void p_conv(const Params& p) {
    const int tid = threadIdx.x;
    const bf16_t* R1 = (const bf16_t*)(p.ws + WS_R1); bf16_t* QK = (bf16_t*)(p.ws + WS_R2);
    const int dvec = tid & 31, rg = tid >> 5; const int s0 = rg * 8;
    for (int tile = blockIdx.x; tile < 1024; tile += gridDim.x) {
        const int cg8 = tile & 7, rt = tile >> 3;
        const int ch = cg8 * 256 + dvec * 8; const int tok0 = rt * 128; const int seq0 = (rt & 15) * 128;
        const float scale = (cg8 >= 4) ? 0.0625f : 1.0f;
        float cw[4][8], cb[8];
#pragma unroll
        for (int w = 0; w < 4; ++w) { const float4 a = *(const float4*)(p.conv_w + w * 2048 + ch), b = *(const float4*)(p.conv_w + w * 2048 + ch + 4);
            cw[w][0] = a.x; cw[w][1] = a.y; cw[w][2] = a.z; cw[w][3] = a.w; cw[w][4] = b.x; cw[w][5] = b.y; cw[w][6] = b.z; cw[w][7] = b.w; }
        { const float4 a = *(const float4*)(p.conv_b + ch), b = *(const float4*)(p.conv_b + ch + 4);
            cb[0] = a.x; cb[1] = a.y; cb[2] = a.z; cb[3] = a.w; cb[4] = b.x; cb[5] = b.y; cb[6] = b.z; cb[7] = b.w; }
        u32x4 raw[11];
#pragma unroll
        for (int i = 0; i < 11; ++i) {
            const int rr = s0 - 3 + i;
            if (seq0 + rr >= 0) raw[i] = __builtin_nontemporal_load((const u32x4*)(R1 + (size_t)(tok0 + rr) * 5120 + ch)); else raw[i] = (u32x4){0u, 0u, 0u, 0u};
        }
#pragma unroll
        for (int i = 0; i < 8; ++i) {
            float o[8];
#pragma unroll
            for (int e = 0; e < 8; ++e) o[e] = cb[e];
#pragma unroll
            for (int w = 0; w < 4; ++w) { float f[8]; unpack8(raw[i + w], f);
#pragma unroll
                for (int e = 0; e < 8; ++e) o[e] += cw[w][e] * f[e]; }
#pragma unroll
            for (int e = 0; e < 8; ++e) o[e] = siluf_(o[e]) * scale;
            st_wt16(QK + (size_t)(tok0 + s0 + i) * 2048 + ch, pack8(o));
        }
    }
}

__device__ __forceinline__ void p2_mlstm(const Params& p, LAS unsigned char* lds) {
    const int tid = threadIdx.x, wid = __builtin_amdgcn_readfirstlane(tid >> 6), lane = tid & 63, r = lane & 15, q = lane >> 4;
    unsigned char* ws = p.ws;
    const bf16_t* R1 = (const bf16_t*)(ws + WS_R1); const bf16_t* QK = (const bf16_t*)(ws + WS_R2);
    const float* GATES = (const float*)(ws + WS_GATES);
    float* SSQ = (float*)(ws + WS_SSQ);
    bf16_t* HM = (bf16_t*)((unsigned char*)p.out + OUT_HM);
    LAS unsigned char* KB = lds + ML_KB; LAS unsigned char* VT = lds + ML_VT; LAS unsigned char* CT = lds + ML_CT; LAS unsigned char* WVT = lds + ML_WVT;
    LAS unsigned char* NV = lds + 149760;
    LAS unsigned char* WV = lds + 150272;
    LAS float* PU = (LAS float*)(lds + ML_G); LAS float* PCM = PU + 2048; LAS float* PB = PU + 4096; LAS float* PBT = PU + 6144; LAS float* PCT = PBT + 16; LAS float* MPREV = PBT + 32; LAS float* MM127 = PBT + 48;
    for (int it = blockIdx.x; it < 256; it += gridDim.x) {
        const int xcd = it & 7, idx = it >> 3; const int bh = xcd * 4 + (idx >> 3), sl = idx & 7; const int b = bh >> 2, h = bh & 3;
        const int tokbase = b * SEQ;
        f32x4 cacc[3][2];
#pragma unroll
        for (int vt = 0; vt < 3; ++vt)
#pragma unroll
            for (int dd = 0; dd < 2; ++dd) cacc[vt][dd] = (f32x4){0.f, 0.f, 0.f, 0.f};
        for (int i = tid; i < (ML_G - ML_VT) / 4; i += 512) ((LAS unsigned*)(lds + ML_VT))[i] = 0u;
#pragma unroll 1
        for (int cc = 0; cc < 2; ++cc) {
            const int ck = 2 * wid + cc; const int t0 = tokbase + ck * 128 + 2 * lane;
            const float ig0 = GATES[(size_t)t0 * 8 + h], lf0 = GATES[(size_t)t0 * 8 + 4 + h], ig1 = GATES[(size_t)(t0 + 1) * 8 + h], lf1 = GATES[(size_t)(t0 + 1) * 8 + 4 + h];
            float sc = lf0 + lf1;
#pragma unroll
            for (int off = 1; off < 64; off <<= 1) { const float t = __shfl_up(sc, off); if (lane >= off) sc += t; }
            const float b1 = sc, b0 = sc - lf1;
            const float u0 = ig0 - b0, u1 = ig1 - b1;
            float cm = fmaxf(u0, u1);
#pragma unroll
            for (int off = 1; off < 64; off <<= 1) { const float t = __shfl_up(cm, off); if (lane >= off) cm = fmaxf(cm, t); }
            float cprev = __shfl_up(cm, 1); if (lane == 0) cprev = -1e30f;
            const int gi = ck * 128 + 2 * lane;
            PU[gi] = u0; PU[gi + 1] = u1; PCM[gi] = fmaxf(cprev, u0); PCM[gi + 1] = cm; PB[gi] = b0; PB[gi + 1] = b1;
            if (lane == 63) { PBT[ck] = b1; PCT[ck] = cm; }
        }
        __syncthreads();
        if (tid < 128) ((LAS unsigned*)NV)[tid] = 0u;
        if (tid == 0) {
            float mprev = 0.f;
#pragma unroll 1
            for (int c = 0; c < 16; ++c) { const float mm = fmaxf(mprev, PCT[c]); MPREV[c] = mprev; MM127[c] = mm; mprev = PBT[c] + mm; }
        }
        u32x4 kreg[8], vreg, qfn[8];
        const unsigned qoff = ((unsigned)(16 * wid + r) * 2048u + (unsigned)(h * 256 + 8 * q)) * 2u;
        const unsigned koff = ((unsigned)(tid >> 5) * 2048u + 1024u + (unsigned)(h * 256) + (unsigned)(tid & 31) * 8u) * 2u;
        const unsigned voff = ((unsigned)(tid >> 2) * 5120u + 2048u + (unsigned)(h * 256 + sl * 32) + (unsigned)(tid & 3) * 8u) * 2u;
        const unsigned ooff = ((unsigned)(16 * wid + r) * 5120u + 3072u + (unsigned)(h * 256 + sl * 32 + 4 * q)) * 2u;
        const unsigned hoff = ((unsigned)(16 * wid + r) * 1024u + (unsigned)(h * 256 + sl * 32 + 4 * q)) * 2u;
        {
            const bf16_t* qkc = QK + (size_t)tokbase * 2048; const bf16_t* r1c = R1 + (size_t)tokbase * 5120;
#pragma unroll
            for (int kk = 0; kk < 8; ++kk) qfn[kk] = ldg16(qkc, qoff + 64u * kk);
#pragma unroll
            for (int i = 0; i < 8; ++i) kreg[i] = ldg16(qkc, koff + 65536u * i);
            vreg = ldg16(r1c, voff);
        }
        __syncthreads();
        for (int chunk = 0; chunk < 16; ++chunk) {
            const int tok0 = tokbase + chunk * 128;
            bf16x8 qf[8];
            {
#pragma unroll
                for (int kk = 0; kk < 8; ++kk) qf[kk] = __builtin_bit_cast(bf16x8, qfn[kk]);
#pragma unroll
                for (int i = 0; i < 8; ++i) { const int vec = tid + 512 * i; *(LAS u32x4*)(KB + (vec >> 5) * KB_STRIDE + (vec & 31) * 16) = kreg[i]; }
                const int s = tid >> 2, vq = tid & 3;
                const float wgt = __expf(PU[chunk * 128 + s] - MM127[chunk]);
                float vf[8]; unpack8(vreg, vf);
#pragma unroll
                for (int e = 0; e < 8; ++e) vf[e] *= wgt;
                *(LAS u32x4*)(VT + s * VR_STRIDE + vq * 16) = vreg;
                *(LAS u32x4*)(WVT + s * VR_STRIDE + vq * 16) = pack8(vf);
                if (vq == 0) *(LAS bf16_t*)(WV + s * 2) = f2bf(wgt);
            }
            __syncthreads();
            u32x2 owr[2], zwr[2];
            {
                const bf16_t* r1c = R1 + (size_t)tok0 * 5120;
#pragma unroll
                for (int vt = 0; vt < 2; ++vt) { owr[vt] = ldg8(r1c, ooff + 32u * vt); zwr[vt] = ldg8(r1c, ooff + 2048u + 32u * vt); }
            }
            const int gl0 = chunk * 128;
            const float mprev = MPREV[chunk], mm127 = MM127[chunk];
            {
                const int l = 16 * wid + r;
                const float mml = fmaxf(mprev, PCM[gl0 + l]);
                f32x4 hacc[3];
                for (int mrep = 0; mrep < MLX2; ++mrep) {
#pragma unroll
                for (int vt = 0; vt < 3; ++vt) hacc[vt] = (f32x4){0.f, 0.f, 0.f, 0.f};
#pragma unroll
                for (int kh = 0; kh < 4; ++kh) {
                    bf16x8 af[2][3];
#pragma unroll
                    for (int k4 = 0; k4 < 2; ++k4)
                    {
#pragma unroll
                        for (int vt = 0; vt < 2; ++vt) {
                            const u32x2 lo = tr_read(CT + (32 * (2 * kh + k4) + 8 * q + (r >> 2)) * VR_STRIDE + (16 * vt + 4 * (r & 3)) * 2);
                            const u32x2 hi = tr_read(CT + (32 * (2 * kh + k4) + 8 * q + 4 + (r >> 2)) * VR_STRIDE + (16 * vt + 4 * (r & 3)) * 2);
                            u32x4 cw; cw.x = lo.x; cw.y = lo.y; cw.z = hi.x; cw.w = hi.y; af[k4][vt] = __builtin_bit_cast(bf16x8, cw);
                        }
                        u32x4 nz = (u32x4){0u, 0u, 0u, 0u};
                        if (r == 0) nz = *(const LAS u32x4*)(NV + (32 * (2 * kh + k4) + 8 * q) * 2);
                        af[k4][2] = __builtin_bit_cast(bf16x8, nz);
                    }
                    __builtin_amdgcn_sched_barrier(0);
#pragma unroll
                    for (int k4 = 0; k4 < 2; ++k4)
#pragma unroll
                        for (int vt = 0; vt < 3; ++vt) hacc[vt] = __builtin_amdgcn_mfma_f32_16x16x32_bf16(af[k4][vt], qf[2 * kh + k4], hacc[vt], 0, 0, 0);
                    __builtin_amdgcn_sched_barrier(0);
                }
                const float inter = __expf(mprev - mml);
#pragma unroll
                for (int vt = 0; vt < 3; ++vt) hacc[vt] *= inter;
                {
                    const int nb = 4 * ((wid >> 1) + 1);
                    bf16x8 fa0[2], fa1[2], fb0[2], fb1[2];
#define ML_LDB(d0, d1, bb) do { _Pragma("unroll") for (int k4 = 0; k4 < 2; ++k4) { \
                        d0[k4] = *(const LAS bf16x8*)(KB + (32 * ((bb) >> 2) + r) * KB_STRIDE + (32 * (2 * ((bb) & 3) + k4) + 8 * q) * 2); \
                        d1[k4] = *(const LAS bf16x8*)(KB + (32 * ((bb) >> 2) + 16 + r) * KB_STRIDE + (32 * (2 * ((bb) & 3) + k4) + 8 * q) * 2); } } while (0)
                    ML_LDB(fa0, fa1, 0);
                    f32x4 s0 = (f32x4){0.f, 0.f, 0.f, 0.f}, s1 = s0;
#pragma unroll
                    for (int bb = 0; bb < 16; ++bb) {
                        if (bb < nb) {
                            if (bb + 1 < nb) { if (bb & 1) ML_LDB(fa0, fa1, bb + 1); else ML_LDB(fb0, fb1, bb + 1); }
                            __builtin_amdgcn_sched_barrier(0);
#pragma unroll
                            for (int k4 = 0; k4 < 2; ++k4) {
                                s0 = __builtin_amdgcn_mfma_f32_16x16x32_bf16((bb & 1) ? fb0[k4] : fa0[k4], qf[2 * (bb & 3) + k4], s0, 0, 0, 0);
                                s1 = __builtin_amdgcn_mfma_f32_16x16x32_bf16((bb & 1) ? fb1[k4] : fa1[k4], qf[2 * (bb & 3) + k4], s1, 0, 0, 0);
                            }
                            __builtin_amdgcn_sched_barrier(0);
                            if ((bb & 3) == 3) {
                                const int sp = bb >> 2;
                                const f32x4 u0 = *(const LAS f32x4*)(PU + gl0 + 32 * sp + 4 * q), u1 = *(const LAS f32x4*)(PU + gl0 + 32 * sp + 16 + 4 * q);
                                if (2 * sp < wid) {
#pragma unroll
                                    for (int j = 0; j < 4; ++j) s0[j] *= __expf(u0[j] - mml);
                                } else {
#pragma unroll
                                    for (int j = 0; j < 4; ++j) s0[j] = (4 * q + j <= r) ? s0[j] * __expf(u0[j] - mml) : 0.f;
                                }
                                if (2 * sp + 1 < wid) {
#pragma unroll
                                    for (int j = 0; j < 4; ++j) s1[j] *= __expf(u1[j] - mml);
                                } else if (2 * sp + 1 == wid) {
#pragma unroll
                                    for (int j = 0; j < 4; ++j) s1[j] = (4 * q + j <= r) ? s1[j] * __expf(u1[j] - mml) : 0.f;
                                } else {
                                    s1 = (f32x4){0.f, 0.f, 0.f, 0.f};
                                }
                                u32x4 bw; bw.x = cvt_pk_bf16(s0[0], s0[1]); bw.y = cvt_pk_bf16(s0[2], s0[3]); bw.z = cvt_pk_bf16(s1[0], s1[1]); bw.w = cvt_pk_bf16(s1[2], s1[3]);
                                const bf16x8 bfrag = __builtin_bit_cast(bf16x8, bw);
#pragma unroll
                                for (int vt = 0; vt < 2; ++vt) {
                                    const u32x2 lo = tr_read(VT + (32 * sp + 4 * q + (r >> 2)) * VR_STRIDE + (16 * vt + 4 * (r & 3)) * 2);
                                    const u32x2 hi = tr_read(VT + (32 * sp + 16 + 4 * q + (r >> 2)) * VR_STRIDE + (16 * vt + 4 * (r & 3)) * 2);
                                    u32x4 aw; aw.x = lo.x; aw.y = lo.y; aw.z = hi.x; aw.w = hi.y;
                                    hacc[vt] = __builtin_amdgcn_mfma_f32_16x16x32_bf16(__builtin_bit_cast(bf16x8, aw), bfrag, hacc[vt], 0, 0, 0);
                                }
                                { const unsigned one2 = (r == 0) ? 0x3F803F80u : 0u; const u32x4 ow = (u32x4){one2, one2, one2, one2};
                                  hacc[2] = __builtin_amdgcn_mfma_f32_16x16x32_bf16(__builtin_bit_cast(bf16x8, ow), bfrag, hacc[2], 0, 0, 0); }
                                s0 = (f32x4){0.f, 0.f, 0.f, 0.f}; s1 = s0;
                            }
                        }
                    }
#undef ML_LDB
                }
                }
                const float den = __shfl(hacc[2][0], r);
                const float dn = fmaxf(fabsf(den), __expf(-(PB[gl0 + l] + mml)));
                const float rdn = 1.0f / dn;
                const int t = tok0 + l;
                float ssq = 0.f;
#pragma unroll
                for (int vt = 0; vt < 2; ++vt) {
                    const int c = h * 256 + sl * 32 + 16 * vt + 4 * q;
                    const u32x2 ow = owr[vt], zw = zwr[vt];
                    const float4 nw = *(const float4*)(p.m_norm_w + c);
                    const float og[4] = {bflo(ow.x), bfhi(ow.x), bflo(ow.y), bfhi(ow.y)};
                    const float zg[4] = {bflo(zw.x), bfhi(zw.x), bflo(zw.y), bfhi(zw.y)};
                    const float nwv[4] = {nw.x, nw.y, nw.z, nw.w};
                    float uo[4];
#pragma unroll
                    for (int j = 0; j < 4; ++j) { const float hs = hacc[vt][j] * rdn * sigmoidf_(og[j]); ssq += hs * hs; uo[j] = hs * nwv[j] * siluf_(zg[j]); }
                    u32x2 w; w.x = cvt_pk_bf16(uo[0], uo[1]); w.y = cvt_pk_bf16(uo[2], uo[3]);
                    stg8(HM + (size_t)tok0 * 1024, hoff + 32u * vt, w);
                }
                ssq += __shfl_xor(ssq, 16); ssq += __shfl_xor(ssq, 32);
                if (q == 0) SSQ[((size_t)t * 4 + h) * 8 + sl] = ssq;
                if (chunk < 15) {
                    const bf16_t* qkc = QK + (size_t)(tok0 + 128) * 2048; const bf16_t* r1c = R1 + (size_t)(tok0 + 128) * 5120;
#pragma unroll
                    for (int kk = 0; kk < 8; ++kk) qfn[kk] = ldg16(qkc, qoff + 64u * kk);
#pragma unroll
                    for (int i = 0; i < 8; ++i) kreg[i] = ldg16(qkc, koff + 65536u * i);
                    vreg = ldg16(r1c, voff);
                }

                const float decay = __expf(mprev - mm127);
#pragma unroll
                for (int vt = 0; vt < 3; ++vt)
#pragma unroll
                    for (int dd = 0; dd < 2; ++dd) cacc[vt][dd] *= decay;
#pragma unroll
                for (int kk = 0; kk < 4; ++kk) {
                    bf16x8 kb[2], wa[3];
#pragma unroll
                    for (int dd = 0; dd < 2; ++dd) {
                        const u32x2 lo = tr_read(KB + (32 * kk + 8 * q + (r >> 2)) * KB_STRIDE + (16 * (2 * wid + dd) + 4 * (r & 3)) * 2);
                        const u32x2 hi = tr_read(KB + (32 * kk + 8 * q + 4 + (r >> 2)) * KB_STRIDE + (16 * (2 * wid + dd) + 4 * (r & 3)) * 2);
                        u32x4 kw; kw.x = lo.x; kw.y = lo.y; kw.z = hi.x; kw.w = hi.y; kb[dd] = __builtin_bit_cast(bf16x8, kw);
                    }
#pragma unroll
                    for (int vt = 0; vt < 2; ++vt) {
                        const u32x2 lo = tr_read(WVT + (32 * kk + 8 * q + (r >> 2)) * VR_STRIDE + (16 * vt + 4 * (r & 3)) * 2);
                        const u32x2 hi = tr_read(WVT + (32 * kk + 8 * q + 4 + (r >> 2)) * VR_STRIDE + (16 * vt + 4 * (r & 3)) * 2);
                        u32x4 ww; ww.x = lo.x; ww.y = lo.y; ww.z = hi.x; ww.w = hi.y; wa[vt] = __builtin_bit_cast(bf16x8, ww);
                    }
                    { u32x4 wz = (u32x4){0u, 0u, 0u, 0u}; if (r == 0) wz = *(const LAS u32x4*)(WV + (32 * kk + 8 * q) * 2); wa[2] = __builtin_bit_cast(bf16x8, wz); }
                    __builtin_amdgcn_sched_barrier(0);
#pragma unroll
                    for (int vt = 0; vt < 3; ++vt)
#pragma unroll
                        for (int dd = 0; dd < 2; ++dd) cacc[vt][dd] = __builtin_amdgcn_mfma_f32_16x16x32_bf16(wa[vt], kb[dd], cacc[vt][dd], 0, 0, 0);
                    __builtin_amdgcn_sched_barrier(0);
                }
            }
            __syncthreads();
#pragma unroll
            for (int vt = 0; vt < 2; ++vt)
#pragma unroll
                for (int dd = 0; dd < 2; ++dd)
                    { u32x2 cw; cw.x = cvt_pk_bf16(cacc[vt][dd][0], cacc[vt][dd][1]); cw.y = cvt_pk_bf16(cacc[vt][dd][2], cacc[vt][dd][3]);
                      *(LAS u32x2*)(CT + (16 * (2 * wid + dd) + r) * VR_STRIDE + (16 * vt + 4 * q) * 2) = cw; }
            if (q == 0) {
#pragma unroll
                for (int dd = 0; dd < 2; ++dd) *(LAS bf16_t*)(NV + (16 * (2 * wid + dd) + r) * 2) = f2bf(cacc[2][dd][0]);
            }
        }
        __syncthreads();
    }
}

constexpr int AT_KA = 0, AT_VB = 69632;
constexpr int KA_STRIDE = 272, VB_STRIDE = 288;
struct AttnItem { int b, g, hh, blk, rr, dil; };
__device__ __forceinline__ AttnItem attn_item(int it) {
    AttnItem a; const int sub = it & 15; a.hh = (it >> 4) & 3; a.g = (it >> 6) % 3; a.b = it / 192;
    const int lg = 2 * a.g; a.dil = 1 << lg; const int nblk = 16 >> lg; a.blk = sub & (nblk - 1); a.rr = sub >> (4 - lg); return a;
}
__device__ __forceinline__ void attn_load(const bf16_t* R1, const AttnItem& a, int tid, u32x4 (&kr)[8], u32x4 (&vr)[8]) {
    const int lg = 2 * a.g;
    const size_t seq = (size_t)a.g * ((size_t)T_TOK * 512) + (size_t)((((a.b * 4 + a.hh) << lg) + a.rr) * (2048 >> lg)) * 128;
    const bf16_t* Kq = (const bf16_t*)((const unsigned char*)R1 + R1_KA) + seq; const bf16_t* Vq = (const bf16_t*)((const unsigned char*)R1 + R1_VA) + seq;
    const int row = tid >> 1, pv = tid & 1; const int jk = a.blk * 128 - 128 + row;
    const u32x4 z = (u32x4){0u, 0u, 0u, 0u};
    if (jk >= 0) { const bf16_t* src = Kq + (size_t)jk * 128; kr[0] = *(const u32x4*)(src + 8 * pv); kr[1] = *(const u32x4*)(src + 16 + 8 * pv); } else { kr[0] = z; kr[1] = z; }
#pragma unroll
    for (int i = 0; i < 6; ++i) {
        const int task = tid + 512 * i; const int row2 = task / 12, v = 4 + task % 12; const int jk2 = a.blk * 128 - 128 + row2;
        kr[2 + i] = (jk2 >= 0) ? *(const u32x4*)(Kq + (size_t)jk2 * 128 + v * 8) : z;
    }
#pragma unroll
    for (int vi = 0; vi < 8; ++vi) vr[vi] = (jk >= 0) ? *(const u32x4*)(Vq + (size_t)jk * 128 + pv * 64 + vi * 8) : z;
}
__device__ __forceinline__ void p4_attn(const Params& p, LAS unsigned char* lds, const int dummy) {
    const int tid = threadIdx.x, wid = __builtin_amdgcn_readfirstlane(tid >> 6), lane = tid & 63, r = lane & 15, q = lane >> 4;
    unsigned char* ws = p.ws;
    bf16_t* R1 = (bf16_t*)(ws + WS_R1);
    const float* RC = (const float*)(ws + WS_ROPE); const float* RS = RC + 2048 * 16;
    float* ML = (float*)((unsigned char*)p.out + OUT_ML);
    LAS unsigned char* KA = lds + AT_KA; LAS unsigned char* VB = lds + AT_VB;
    const float QSCALE = 0.08838834764831845f * 1.4426950408889634f;
    u32x4 kr[8], vr[8];
    int it = blockIdx.x;
    if (it < 1536) { const AttnItem a0 = attn_item(it); attn_load(R1, a0, tid, kr, vr); }
    for (; it < 1536; it += gridDim.x) {
        const AttnItem a = attn_item(it);
        const int blk = a.blk, dil = a.dil, rr = a.rr, g = a.g, hh = a.hh;
        const int tokb = a.b * SEQ; const int qcol = g * 512 + hh * 128;
        {
            const int row = tid >> 1, pv = tid & 1; const int jk = blk * 128 - 128 + row;
            u32x4 o1 = kr[0], o2 = kr[1];
            if (jk >= 0) {
                const int pos = jk * dil + rr;
                float x1[8], x2[8]; unpack8(kr[0], x1); unpack8(kr[1], x2);
                const float4 ca = *(const float4*)(RC + pos * 16 + 8 * pv), cb = *(const float4*)(RC + pos * 16 + 8 * pv + 4);
                const float4 sa = *(const float4*)(RS + pos * 16 + 8 * pv), sb = *(const float4*)(RS + pos * 16 + 8 * pv + 4);
                const float cc[8] = {ca.x, ca.y, ca.z, ca.w, cb.x, cb.y, cb.z, cb.w}, sn[8] = {sa.x, sa.y, sa.z, sa.w, sb.x, sb.y, sb.z, sb.w};
                float y1[8], y2[8];
#pragma unroll
                for (int e = 0; e < 8; ++e) { y1[e] = x1[e] * cc[e] - x2[e] * sn[e]; y2[e] = x2[e] * cc[e] + x1[e] * sn[e]; }
                o1 = pack8(y1); o2 = pack8(y2);
            }
            *(LAS u32x4*)(KA + row * KA_STRIDE + (8 * pv) * 2) = o1;
            *(LAS u32x4*)(KA + row * KA_STRIDE + (16 + 8 * pv) * 2) = o2;
#pragma unroll
            for (int i = 0; i < 6; ++i) { const int task = tid + 512 * i; const int row2 = task / 12, v = 4 + task % 12; *(LAS u32x4*)(KA + row2 * KA_STRIDE + v * 16) = kr[2 + i]; }
#pragma unroll
            for (int vi = 0; vi < 8; ++vi) *(LAS u32x4*)(VB + row * VB_STRIDE + (pv * 64 + vi * 8) * 2) = vr[vi];
        }
        const int ql = 16 * wid + r; const int jq = blk * 128 + ql; const int posq = jq * dil + rr; const size_t tq = (size_t)(tokb + posq);
        bf16x8 qf[4];
        {
            bf16_t* qsrc = R1 + tq * QZ_LD + qcol;
#pragma unroll
            for (int kk = 0; kk < 4; ++kk) {
                const u32x4 av = *(const u32x4*)(qsrc + 32 * kk + 8 * q);
                float x[8]; unpack8(av, x);
                if (kk == 0) {
                    const int fi = 8 * (q & 1);
                    const float4 ca = *(const float4*)(RC + posq * 16 + fi), cb = *(const float4*)(RC + posq * 16 + fi + 4);
                    const float4 sa = *(const float4*)(RS + posq * 16 + fi), sb = *(const float4*)(RS + posq * 16 + fi + 4);
                    const float cc[8] = {ca.x, ca.y, ca.z, ca.w, cb.x, cb.y, cb.z, cb.w}, sn[8] = {sa.x, sa.y, sa.z, sa.w, sb.x, sb.y, sb.z, sb.w};
#pragma unroll
                    for (int e = 0; e < 8; ++e) { const float xo = __shfl_xor(x[e], 32); x[e] = (q < 2) ? (x[e] * cc[e] - xo * sn[e]) : (x[e] * cc[e] + xo * sn[e]); }
                }
#pragma unroll
                for (int e = 0; e < 8; ++e) x[e] *= QSCALE;
                qf[kk] = __builtin_bit_cast(bf16x8, pack8(x));
            }
        }
        __syncthreads();
        if (it + (int)gridDim.x < 1536) { const AttnItem an = attn_item(it + gridDim.x); attn_load(R1, an, tid, kr, vr); }
        const int ilo = (blk == 0) ? 8 - wid : 0;
        f32x4 sT[9];
#pragma unroll
        for (int i = 0; i < 9; ++i) sT[i] = (f32x4){0.f, 0.f, 0.f, 0.f};
#pragma unroll
        for (int gi = 0; gi < 3; ++gi) {
            if (3 * gi + 2 >= ilo) {
                bf16x8 ka[3][4];
#pragma unroll
                for (int i3 = 0; i3 < 3; ++i3)
#pragma unroll
                    for (int kk = 0; kk < 4; ++kk) ka[i3][kk] = *(const LAS bf16x8*)(KA + (16 * (wid + 3 * gi + i3) + r) * KA_STRIDE + (32 * kk + 8 * q) * 2);
                __builtin_amdgcn_sched_barrier(0);
#pragma unroll
                for (int kk = 0; kk < 4; ++kk)
#pragma unroll
                    for (int i3 = 0; i3 < 3; ++i3) sT[3 * gi + i3] = __builtin_amdgcn_mfma_f32_16x16x32_bf16(ka[i3][kk], qf[kk], sT[3 * gi + i3], 0, 0, 0);
                __builtin_amdgcn_sched_barrier(0);
            }
        }
        float mx = -1e30f;
#pragma unroll
        for (int i = 0; i < 9; ++i)
#pragma unroll
            for (int j = 0; j < 4; ++j) {
                const int kl = 16 * (wid + i) + 4 * q + j; const int dist = ql - kl + 128; const int jk = blk * 128 - 128 + kl;
                const bool valid = (dist >= 0) && (dist <= 128) && (jk >= 0);
                sT[i][j] = valid ? sT[i][j] : -1e30f; mx = fmaxf(mx, sT[i][j]);
            }
        mx = fmaxf(mx, __shfl_xor(mx, 16)); mx = fmaxf(mx, __shfl_xor(mx, 32));
        float lsum = 0.f;
#pragma unroll
        for (int i = 0; i < 9; ++i)
#pragma unroll
            for (int j = 0; j < 4; ++j) { const float pe = (sT[i][j] > -1e29f) ? exp2f(sT[i][j] - mx) : 0.f; sT[i][j] = pe; lsum += pe; }
        lsum += __shfl_xor(lsum, 16); lsum += __shfl_xor(lsum, 32);
        f32x4 oacc[8];
#pragma unroll
        for (int et = 0; et < 8; ++et) oacc[et] = (f32x4){0.f, 0.f, 0.f, 0.f};
#pragma unroll
        for (int ps = 0; ps < 5; ++ps) {
            if (2 * ps + 1 >= ilo) {
                u32x4 bw; bw.x = cvt_pk_bf16(sT[2 * ps][0], sT[2 * ps][1]); bw.y = cvt_pk_bf16(sT[2 * ps][2], sT[2 * ps][3]);
                if (ps < 4) { bw.z = cvt_pk_bf16(sT[(2 * ps + 1) % 9][0], sT[(2 * ps + 1) % 9][1]); bw.w = cvt_pk_bf16(sT[(2 * ps + 1) % 9][2], sT[(2 * ps + 1) % 9][3]); } else { bw.z = 0u; bw.w = 0u; }
                const bf16x8 bfrag = __builtin_bit_cast(bf16x8, bw);
                u32x2 vlo[8], vhi[8];
#pragma unroll
                for (int et = 0; et < 8; ++et) {
                    vlo[et] = tr_read(VB + (16 * (wid + 2 * ps) + 4 * q + (r >> 2)) * VB_STRIDE + (16 * et + 4 * (r & 3)) * 2);
                    vhi[et] = (u32x2){0u, 0u};
                    if (ps < 4) vhi[et] = tr_read(VB + (16 * (wid + 2 * ps + 1) + 4 * q + (r >> 2)) * VB_STRIDE + (16 * et + 4 * (r & 3)) * 2);
                }
                __builtin_amdgcn_sched_barrier(0);
#pragma unroll
                for (int et = 0; et < 8; ++et) {
                    u32x4 aw; aw.x = vlo[et].x; aw.y = vlo[et].y; aw.z = vhi[et].x; aw.w = vhi[et].y;
                    oacc[et] = __builtin_amdgcn_mfma_f32_16x16x32_bf16(__builtin_bit_cast(bf16x8, aw), bfrag, oacc[et], 0, 0, 0);
                }
                __builtin_amdgcn_sched_barrier(0);
            }
        }
        const float rl = 1.0f / lsum;
        {
            bf16_t* odst = dummy ? (bf16_t*)((unsigned char*)p.out + 8388608 + ((tq * 1536 + qcol) * 2 & 16777215)) : R1 + tq * QZ_LD + qcol;
#pragma unroll
            for (int et = 0; et < 8; ++et) {
                u32x2 w; w.x = cvt_pk_bf16(oacc[et][0] * rl, oacc[et][1] * rl); w.y = cvt_pk_bf16(oacc[et][2] * rl, oacc[et][3] * rl);
                *(u32x2*)(odst + 16 * et + 4 * q) = w;
            }
            if (q == 0) { float2 mlv; mlv.x = mx; mlv.y = lsum; *(float2*)(ML + (tq * 12 + g * 4 + hh) * 2) = mlv; }
        }
        __syncthreads();
    }
}

__device__ __forceinline__ void p5_fixup(const Params& p) {
    const int tid = threadIdx.x, G = gridDim.x, bid = blockIdx.x;
    unsigned char* ws = p.ws;
    const bf16_t* R1 = (const bf16_t*)(ws + WS_R1);
    const float* SSQ = (const float*)(ws + WS_SSQ);
    bf16_t* HM = (bf16_t*)((unsigned char*)p.out + OUT_HM);
    const float* ML = (const float*)((unsigned char*)p.out + OUT_ML);
    bf16_t* ATT = (bf16_t*)((unsigned char*)p.out + OUT_ATT);
    const int gtid = bid * 512 + tid, gsz = G * 512;
    for (int v0 = gtid; v0 < T_TOK * 128; v0 += 4 * gsz) {
        u32x4 hv[4]; float4 s0[4], s1[4];
#pragma unroll
        for (int u = 0; u < 4; ++u) { const int v = v0 + u * gsz; if (v < T_TOK * 128) { const int row = v >> 7, head = (v >> 5) & 3;
            hv[u] = __builtin_nontemporal_load((const u32x4*)(HM + (size_t)v * 8)); s0[u] = *(const float4*)(SSQ + ((size_t)row * 4 + head) * 8); s1[u] = *(const float4*)(SSQ + ((size_t)row * 4 + head) * 8 + 4); } }
#pragma unroll
        for (int u = 0; u < 4; ++u) { const int v = v0 + u * gsz; if (v < T_TOK * 128) {
            const float ss = (s0[u].x + s0[u].y) + (s0[u].z + s0[u].w) + (s1[u].x + s1[u].y) + (s1[u].z + s1[u].w);
            const float rstd = rsqrtf(ss * (1.0f / 256.0f) + EPS);
            float f[8]; unpack8(hv[u], f);
#pragma unroll
            for (int e = 0; e < 8; ++e) f[e] *= rstd;
            st_wt16(HM + (size_t)v * 8, pack8(f)); } }
    }
    for (int v0 = gtid; v0 < T_TOK * 64; v0 += 2 * gsz) {
        u32x4 ov[2][3], zv[2]; float2 ml[2][3];
#pragma unroll
        for (int u = 0; u < 2; ++u) { const int v = v0 + u * gsz; if (v < T_TOK * 64) { const int row = v >> 6, cv = v & 63, hs = cv >> 4;
#pragma unroll
            for (int g = 0; g < 3; ++g) { ml[u][g] = *(const float2*)(ML + ((size_t)row * 12 + g * 4 + hs) * 2); ov[u][g] = __builtin_nontemporal_load((const u32x4*)(R1 + (size_t)row * QZ_LD + g * 512 + cv * 8)); }
            zv[u] = __builtin_nontemporal_load((const u32x4*)(R1 + (size_t)row * QZ_LD + 1536 + cv * 8)); } }
#pragma unroll
        for (int u = 0; u < 2; ++u) { const int v = v0 + u * gsz; if (v < T_TOK * 64) {
            const float M = fmaxf(ml[u][0].x, fmaxf(ml[u][1].x, ml[u][2].x));
            float wt[3], W = 0.f;
#pragma unroll
            for (int g = 0; g < 3; ++g) { wt[g] = exp2f(ml[u][g].x - M) * ml[u][g].y; W += wt[g]; }
            const float rW = 1.0f / W;
            float acc[8];
#pragma unroll
            for (int e = 0; e < 8; ++e) acc[e] = 0.f;
#pragma unroll
            for (int g = 0; g < 3; ++g) { float f[8]; unpack8(ov[u][g], f);
#pragma unroll
                for (int e = 0; e < 8; ++e) acc[e] += wt[g] * f[e]; }
            float z[8]; unpack8(zv[u], z);
#pragma unroll
            for (int e = 0; e < 8; ++e) acc[e] = acc[e] * rW * siluf_(z[e]);
            st_wt16(ATT + (size_t)v * 8, pack8(acc)); } }
    }
}

__device__ __forceinline__ void p8_final(const Params& p) {
    const int tid = threadIdx.x, G = gridDim.x, bid = blockIdx.x, lane = tid & 63, wid = tid >> 6;
    const float* Y = (const float*)(p.ws + WS_R1 + R1_Y);
    for (int row = bid * 8 + wid; row < T_TOK; row += G * 8) {
        const float4* yr = (const float4*)(Y + (size_t)row * 1024); const float4* xr = (const float4*)(p.x + (size_t)row * 1024);
        float4 v[4]; float ss = 0.f;
#pragma unroll
        for (int i = 0; i < 4; ++i) { v[i] = yr[i * 64 + lane]; ss += v[i].x * v[i].x + v[i].y * v[i].y + v[i].z * v[i].z + v[i].w * v[i].w; }
        ss = wave_sum(ss);
        const float rstd = rsqrtf(ss * (1.0f / 1024.0f) + EPS);
#pragma unroll
        for (int i = 0; i < 4; ++i) {
            const float4 pw = ((const float4*)p.post_w)[i * 64 + lane]; const float4 xv = xr[i * 64 + lane];
            float4 o; o.x = xv.x + v[i].x * rstd * pw.x; o.y = xv.y + v[i].y * rstd * pw.y; o.z = xv.z + v[i].z * rstd * pw.z; o.w = xv.w + v[i].w * rstd * pw.w;
            ((float4*)(p.out + (size_t)row * 1024))[i * 64 + lane] = o;
        }
    }
}

__global__ void __launch_bounds__(512, 2) mega_fwd(Params p) {
    extern __shared__ __attribute__((aligned(16))) unsigned char lds_raw[];
    LAS unsigned char* lds = (LAS unsigned char*)lds_raw;
    cg::grid_group grid = cg::this_grid();
    const int lo = p.ph_lo, hi = p.ph_hi;
    unsigned char* ws = p.ws;
    const int G = gridDim.x, bid = blockIdx.x;
#define IN(k) (lo <= (k) && (k) < hi)
    if (threadIdx.x == 0) { ((volatile LAS unsigned*)(lds + LDS_BAR_OFF))[0] = 0u; ((volatile LAS unsigned*)(lds + LDS_BAR_OFF))[1] = 0u; }
    __syncthreads();
    XcdBarrier xbar; xbar.bar = (unsigned*)(ws + WS_BAR); xbar.x = 0; xbar.st = nullptr;
    if (hi - lo > 1) xbar = xcd_barrier_post((unsigned*)(ws + WS_BAR), (volatile LAS unsigned*)(lds + LDS_BAR_OFF));
#define SEAM(k) do { if (IN(k) && IN((k) + 1)) { xcd_barrier(xbar); if (REPB > 1) xcd_barrier(xbar); } } while (0)
    if (lo > 1000) grid.sync();
    bf16_t* H = (bf16_t*)((unsigned char*)p.out + OUT_H);
    bf16_t* HM = (bf16_t*)((unsigned char*)p.out + OUT_HM);
    bf16_t* ATT = (bf16_t*)((unsigned char*)p.out + OUT_ATT);
    bf16_t* WinT = (bf16_t*)(ws + WS_WIN);
    bf16_t* R1 = (bf16_t*)(ws + WS_R1); bf16_t* R2 = (bf16_t*)(ws + WS_R2);
    if (IN(0)) { for (int rep = 0; rep < REP0; ++rep) p0_prep(p, lds); }
    SEAM(0);
    if (IN(1)) {
        pg8::Gemm g{H, WinT, T_TOK, 5120, 1024}; pg8::StaticOrder S; S.init(T_TOK, 5120, G, bid);
        EpiStoreBf16 E{R1, 5120, 1 << 30, R1, 5120};
        for (int rep = 0; rep < REP1; ++rep) pg8::gemm_phase<EpiStoreBf16>(lds, g, S, E);
    }
    SEAM(1);
    if (IN(2)) { for (int rep = 0; rep < REPC; ++rep) p_conv(p); }
    SEAM(2);
    if (IN(3)) { for (int rep = 0; rep < REP2; ++rep) p2_mlstm(p, lds); }
    SEAM(3);
    if (IN(4)) {
        pg8::Gemm g{H, WinT + (size_t)5120 * 1024, T_TOK, 7168, 1024}; pg8::StaticOrder S; S.init(T_TOK, 7168, G, bid);
        EpiProjB E{R1, (bf16_t*)(ws + WS_R1 + R1_KA), (bf16_t*)(ws + WS_R1 + R1_VA), R2};
        for (int rep = 0; rep < REP4; ++rep) pg8::gemm_phase<EpiProjB>(lds, g, S, E);
    }
    SEAM(4);
    if (IN(5)) { for (int rep = 0; rep < REPA; ++rep) p4_attn(p, lds, rep < REPA - 1); }
    SEAM(5);
    if (IN(6)) { p5_fixup(p); }
    SEAM(6);
    if (IN(7)) {
        bf16_t* MG = (bf16_t*)(ws + WS_R1 + R1_MG);
        pg8::Gemm g0{HM, (const bf16_t*)(ws + WS_WPM), T_TOK, 1024, 1024}; pg8::Gemm g1{ATT, (const bf16_t*)(ws + WS_WPA), T_TOK, 1024, 512};
        pg8::StaticOrder S; S.init(T_TOK, 1024, G, bid);
        EpiRatio E0{R2}; EpiMerge2 E1{R2, MG};
        pg8::gemm_phase2<EpiRatio, EpiMerge2>(lds, g0, g1, S, E0, E1);
    }
    SEAM(7);
    const bool fuse_out = (G == 256);
    if (IN(8)) {
        pg8::Gemm g{(const bf16_t*)(ws + WS_R1 + R1_MG), (const bf16_t*)(ws + WS_WOUT), T_TOK, 1024, 1024}; pg8::StaticOrder S; S.init(T_TOK, 1024, G, bid);
        if (fuse_out) { EpiRmsRes E{p.x, p.post_w, p.out, (float*)(ws + WS_R2), (unsigned*)(ws + WS_BAR) + 3600}; pg8::gemm_phase<EpiRmsRes, true>(lds, g, S, E); }
        else { EpiF32 E{(float*)(ws + WS_R1 + R1_Y)}; pg8::gemm_phase<EpiF32>(lds, g, S, E); }
    }
    if (!fuse_out) {
        SEAM(8);
        if (IN(9)) { for (int rep = 0; rep < REP8; ++rep) p8_final(p); }
    }
}

extern "C" void kernel_launch(void* const* d_in, const int* in_sizes, int n_in, void* d_out, int out_size, void* d_ws, size_t ws_size, hipStream_t stream) {
    static int grid = 0;
    if (grid == 0) {
        int dev = 0, cus = 0, per_cu = 0;
        (void)hipGetDevice(&dev);
        (void)hipDeviceGetAttribute(&cus, hipDeviceAttributeMultiprocessorCount, dev);
        (void)hipFuncSetAttribute((const void*)mega_fwd, hipFuncAttributeMaxDynamicSharedMemorySize, LDS_BYTES);
        (void)hipOccupancyMaxActiveBlocksPerMultiprocessor(&per_cu, (const void*)mega_fwd, 512, LDS_BYTES);
        (void)hipGetLastError();
        if (per_cu < 1) per_cu = 1;
        if (per_cu > 1) per_cu = 1;
        grid = cus * per_cu;
        if (ws_size < WS_END) fprintf(stderr, "kernel_launch: workspace too small: %zu < %zu\n", ws_size, (size_t)WS_END);
    }
    Params p{};
    p.x = (const float*)d_in[0]; p.pre_w = (const float*)d_in[1]; p.w_in = (const float*)d_in[2]; p.b_if = (const float*)d_in[3];
    p.conv_w = (const float*)d_in[4]; p.conv_b = (const float*)d_in[5]; p.m_norm_w = (const float*)d_in[6]; p.w_pm = (const float*)d_in[7];
    p.w_pa = (const float*)d_in[8]; p.w_out = (const float*)d_in[9]; p.post_w = (const float*)d_in[10];
    p.out = (float*)d_out; p.ws = (unsigned char*)d_ws; p.ph_lo = 0; p.ph_hi = 10;
    (void)hipMemsetAsync((unsigned char*)d_ws + WS_BAR, 0, 16384, stream);
    void* args[] = {&p};
    hipError_t e = hipLaunchCooperativeKernel((const void*)mega_fwd, dim3(grid), dim3(512), args, LDS_BYTES, stream);
    if (e != hipSuccess) fprintf(stderr, "cooperative launch failed: %s (grid %d)\n", hipGetErrorString(e), grid);
}
```
